# Optimizing an MI355X kernel written in HIP

```python
import jax, jax.numpy as jnp
from jax import lax
import numpy as np

D_MODEL = 1024
BATCH = 4
SEQ = 8192
DEPTH = 1

CTX_LEN = 256
GRID_W = 64
D_MIX = D_MODEL
D_POOL = D_MIX // 2
POOL_WINDOWS = (2, 4, 8, 16)
N_POOL_GROUPS = len(POOL_WINDOWS)
POOL_GROUP_DIM = D_POOL // N_POOL_GROUPS
D_HGRN = D_MIX - D_POOL
HG_HEAD_DIM = 128
HG_HEADS = D_HGRN // HG_HEAD_DIM
CHUNK = 64
D_IN = D_POOL + 5 * D_HGRN
N_GROUPS = 4
EXPERTS_PER_GROUP = 8
N_EXPERTS = N_GROUPS * EXPERTS_PER_GROUP
TOP_K = 2
D_EXPERT = D_MODEL // 2
MOE_BLOCK = 128
EPS = 1e-6

kernel_name = 'hybrid_pool_hgrn2_hmoe_dit_block'


def rmsnorm(x, g):
    xf = x.astype(jnp.float32)
    y = xf * lax.rsqrt(jnp.mean(xf * xf, axis=-1, keepdims=True) + EPS)
    return (y * g.astype(jnp.float32)).astype(x.dtype)


def adaln(cond, w_ada, b_ada):
    m = jax.nn.silu(cond.astype(jnp.float32)) @ w_ada.astype(jnp.float32) + b_ada.astype(jnp.float32)
    return jnp.split(m, 6, axis=-1)


def modulate(h, shift, scale):
    return (h.astype(jnp.float32) * (1.0 + scale) + shift).astype(h.dtype)


def box_mean_1d(v, w):
    n = v.shape[1]
    cs = jnp.pad(jnp.cumsum(v, axis=1), ((0, 0), (1, 0), (0, 0)))
    t = jnp.arange(n)
    lo = jnp.clip(t - w // 2, 0, n)
    hi = jnp.clip(t + w // 2, 0, n)
    return (cs[:, hi] - cs[:, lo]) / (hi - lo).astype(jnp.float32)[None, :, None]


def box_mean_2d(v, w):
    rows, cols = v.shape[1], v.shape[2]
    sat = jnp.pad(jnp.cumsum(jnp.cumsum(v, axis=1), axis=2), ((0, 0), (1, 0), (1, 0), (0, 0)))
    r = jnp.arange(rows)
    cc = jnp.arange(cols)
    r0 = jnp.clip(r - w // 2, 0, rows)
    r1 = jnp.clip(r + w // 2, 0, rows)
    c0 = jnp.clip(cc - w // 2, 0, cols)
    c1 = jnp.clip(cc + w // 2, 0, cols)

    def corner(ri, ci):
        return sat[:, ri][:, :, ci]

    s = corner(r1, c1) - corner(r0, c1) - corner(r1, c0) + corner(r0, c0)
    cnt = ((r1 - r0)[:, None] * (c1 - c0)[None, :]).astype(jnp.float32)
    return s / cnt[None, :, :, None]


def pool_mixer(v, w_pool, s_pool, grid):
    b_, n, _ = v.shape
    vf = v.astype(jnp.float32)
    outs = []
    for gi, w in enumerate(POOL_WINDOWS):
        vg = vf[..., gi * POOL_GROUP_DIM:(gi + 1) * POOL_GROUP_DIM]
        if grid:
            rows = n // GRID_W
            m = box_mean_2d(vg.reshape(b_, rows, GRID_W, POOL_GROUP_DIM), w).reshape(b_, n, POOL_GROUP_DIM)
        else:
            m = box_mean_1d(vg, w)
        outs.append(m - vg)
    d = jnp.stack(outs, axis=2)
    y = jnp.einsum('bngc,gce->bnge', d, w_pool.astype(jnp.float32)).reshape(b_, n, D_POOL)
    return (y * s_pool.astype(jnp.float32)).astype(v.dtype)


def to_heads(t):
    b_, n, _ = t.shape
    return t.reshape(b_, n, HG_HEADS, HG_HEAD_DIM).transpose(0, 2, 1, 3).astype(jnp.float32)


def forget_gate(z, lb):
    lbh = lb.astype(jnp.float32).reshape(HG_HEADS, 1, HG_HEAD_DIM)
    log_f = jnp.logaddexp(jnp.log(lbh), jnp.log1p(-lbh) + jax.nn.log_sigmoid(z))
    return log_f, -jnp.expm1(log_f)


def gla_chunk_scan(q, k, v, log_f, s0):
    b_, h, n, dk = q.shape
    dv = v.shape[-1]
    nc = n // CHUNK

    def chunks(t):
        return t.reshape(b_, h, nc, CHUNK, t.shape[-1]).transpose(2, 0, 1, 3, 4)

    causal = jnp.tril(jnp.ones((CHUNK, CHUNK), dtype=bool))[:, :, None]

    def step(state, inp):
        qb, kb, vb, gb = inp
        bcum = jnp.cumsum(gb, axis=2)
        diff = bcum[:, :, :, None, :] - bcum[:, :, None, :, :]
        decay = jnp.exp(jnp.where(causal, diff, -jnp.inf))
        scores = jnp.einsum('bhtsd,bhsd->bhts', qb[:, :, :, None, :] * decay, kb)
        o = jnp.einsum('bhts,bhsv->bhtv', scores, vb) + jnp.einsum('bhtd,bhdv->bhtv', qb * jnp.exp(bcum), state)
        b_last = bcum[:, :, -1:, :]
        new_state = jnp.exp(b_last[:, :, 0, :])[..., None] * state + jnp.einsum('bhsd,bhsv->bhdv', kb * jnp.exp(b_last - bcum), vb)
        return new_state, o

    s_fin, o = lax.scan(step, s0, (chunks(q), chunks(k), chunks(v), chunks(log_f)))
    return o.transpose(1, 2, 0, 3, 4).reshape(b_, h, n, dv), s_fin


def hgrn_bidir(p, lb_f, lb_b, s0f, s0b):
    q = jax.nn.silu(to_heads(p[1]))
    v = to_heads(p[2])
    lf, kf = forget_gate(to_heads(p[3]), lb_f)
    lbw, kbw = forget_gate(to_heads(p[4]), lb_b)
    of, sf = gla_chunk_scan(q, kf, v, lf, s0f)

    def rev(t):
        return t[:, :, ::-1]

    ob, sb = gla_chunk_scan(rev(q), rev(kbw), rev(v), rev(lbw), s0b)
    return of + rev(ob), sf, sb


def hgrn_readout(o, g, g_hnorm, dtype):
    o = o * lax.rsqrt(jnp.mean(o * o, axis=-1, keepdims=True) + EPS) * g_hnorm.astype(jnp.float32)
    b_, h, n, dv = o.shape
    o = o.transpose(0, 2, 1, 3).reshape(b_, n, h * dv)
    return (o * jax.nn.silu(g.astype(jnp.float32))).astype(dtype)


def split_in(p):
    return jnp.split(p, [D_POOL + i * D_HGRN for i in range(5)], axis=-1)


def mixer_output(p, o, w_pool, s_pool, g_hnorm, w_out, grid):
    y_pool = pool_mixer(p[0], w_pool, s_pool, grid)
    y_hgrn = hgrn_readout(o, p[5], g_hnorm, p[0].dtype)
    return jnp.concatenate([y_pool, y_hgrn], axis=-1) @ w_out


def hier_moe(h, w_group, b_group, w_router, b_router, w1, w3, w2):
    t_, d_ = h.shape
    hf = h.astype(jnp.float32)
    grp_prob = jax.nn.softmax(hf @ w_group.astype(jnp.float32) + b_group.astype(jnp.float32), axis=-1)
    g_sel = jnp.argmax(grp_prob, axis=-1)
    p_grp = jnp.take_along_axis(grp_prob, g_sel[:, None], axis=1)
    logits = jnp.einsum('td,gde->tge', hf, w_router.astype(jnp.float32)) + b_router.astype(jnp.float32)
    sel_logits = jnp.take_along_axis(logits, g_sel[:, None, None], axis=1)[:, 0]
    p_exp = jax.nn.softmax(sel_logits, axis=-1)
    top_p, top_i = lax.top_k(p_exp, TOP_K)
    top_p = top_p / jnp.sum(top_p, axis=-1, keepdims=True)
    gates = (p_grp * top_p).reshape(-1)
    eid = (g_sel[:, None] * EXPERTS_PER_GROUP + top_i).reshape(-1).astype(jnp.int32)
    tok = jnp.repeat(jnp.arange(t_, dtype=jnp.int32), TOP_K)
    n_assign = t_ * TOP_K
    order = jnp.argsort(eid)
    e_s, tok_s, w_s = eid[order], tok[order], gates[order]
    counts = jnp.bincount(eid, length=N_EXPERTS)
    starts = jnp.cumsum(counts) - counts
    padded = (counts + MOE_BLOCK - 1) // MOE_BLOCK * MOE_BLOCK
    ends = jnp.cumsum(padded)
    pstarts = ends - padded
    dest = pstarts[e_s] + (jnp.arange(n_assign) - starts[e_s])
    n_blocks = (n_assign + N_EXPERTS * (MOE_BLOCK - 1) + MOE_BLOCK - 1) // MOE_BLOCK
    n_rows = n_blocks * MOE_BLOCK
    row_tok = jnp.full((n_rows,), t_, dtype=jnp.int32).at[dest].set(tok_s)
    block_e = jnp.clip(jnp.searchsorted(ends, jnp.arange(n_blocks) * MOE_BLOCK, side='right'), 0, N_EXPERTS - 1)
    h_pad = jnp.concatenate([h, jnp.zeros((1, d_), h.dtype)], axis=0)
    xb = h_pad[row_tok].reshape(n_blocks, MOE_BLOCK, d_)

    def expert_block(args):
        xblk, e = args
        return (jax.nn.silu(xblk @ w1[e]) * (xblk @ w3[e])) @ w2[e]

    yb = lax.map(expert_block, (xb, block_e)).reshape(n_rows, d_)
    out = jnp.zeros((t_, d_), jnp.float32).at[tok_s].add(yb[dest].astype(jnp.float32) * w_s[:, None])
    return out.astype(h.dtype)


def setup_inputs(seed: int = 0) -> dict:
    key = jax.random.key(seed)
    ks = jax.random.split(key, 24)

    def nrm(k, shape, scale):
        return jax.random.normal(k, shape, jnp.float32) * scale

    return {
        'x': nrm(ks[0], (BATCH, SEQ, D_MODEL), 1.0),
        'c': nrm(ks[1], (BATCH, D_MODEL), 1.0),
        'ctx': nrm(ks[2], (BATCH, CTX_LEN, D_MODEL), 1.0),
        'c_ctx': nrm(ks[3], (D_MODEL,), 1.0),
        'w_ada': nrm(ks[4], (DEPTH, D_MODEL, 6 * D_MODEL), 0.5 * D_MODEL ** -0.5),
        'b_ada': nrm(ks[5], (DEPTH, 6 * D_MODEL), 0.01),
        'g_mix': 1.0 + nrm(ks[6], (DEPTH, D_MODEL), 0.02),
        'g_ffn': 1.0 + nrm(ks[7], (DEPTH, D_MODEL), 0.02),
        'w_in': nrm(ks[8], (DEPTH, D_MODEL, D_IN), D_MODEL ** -0.5),
        'w_pool': nrm(ks[9], (DEPTH, N_POOL_GROUPS, POOL_GROUP_DIM, POOL_GROUP_DIM), POOL_GROUP_DIM ** -0.5),
        's_pool': 1.0 + nrm(ks[10], (DEPTH, D_POOL), 0.1),
        'lb_logits': nrm(ks[11], (2, DEPTH + 1, D_HGRN), 0.5),
        'g_hnorm': 1.0 + nrm(ks[12], (DEPTH, HG_HEAD_DIM), 0.02),
        'w_out': nrm(ks[13], (DEPTH, D_MIX, D_MODEL), D_MIX ** -0.5),
        'w_group': nrm(ks[14], (DEPTH, D_MODEL, N_GROUPS), D_MODEL ** -0.5),
        'b_group': nrm(ks[15], (DEPTH, N_GROUPS), 0.01),
        'w_router': nrm(ks[16], (DEPTH, N_GROUPS, D_MODEL, EXPERTS_PER_GROUP), D_MODEL ** -0.5),
        'b_router': nrm(ks[17], (DEPTH, N_GROUPS, EXPERTS_PER_GROUP), 0.01),
        'w1': nrm(ks[18], (DEPTH, N_EXPERTS, D_MODEL, D_EXPERT), D_MODEL ** -0.5),
        'w3': nrm(ks[19], (DEPTH, N_EXPERTS, D_MODEL, D_EXPERT), D_MODEL ** -0.5),
        'w2': nrm(ks[20], (DEPTH, N_EXPERTS, D_EXPERT, D_MODEL), D_EXPERT ** -0.5),
        'g_final': 1.0 + nrm(ks[21], (D_MODEL,), 0.02),
    }


def reference(x, c, ctx, c_ctx, w_ada, b_ada, g_mix, g_ffn, w_in, w_pool, s_pool, lb_logits, g_hnorm, w_out,
              w_group, b_group, w_router, b_router, w1, w3, w2, g_final):
    b_, n, d_ = x.shape
    lb_all = jnp.cumsum(jax.nn.softmax(lb_logits.astype(jnp.float32), axis=1), axis=1)
    zero_state = jnp.zeros((b_, HG_HEADS, HG_HEAD_DIM, HG_HEAD_DIM), jnp.float32)
    for l in range(DEPTH):
        sh1, sc1, ga1, sh2, sc2, ga2 = adaln(c[:, None, :], w_ada[l], b_ada[l])
        csh1, csc1, cga1, csh2, csc2, cga2 = adaln(c_ctx[None, None, :], w_ada[l], b_ada[l])
        hx = modulate(rmsnorm(x, g_mix[l]), sh1, sc1)
        hc = modulate(rmsnorm(ctx, g_mix[l]), csh1, csc1)
        px = split_in(hx @ w_in[l])
        pc = split_in(hc @ w_in[l])
        oc, s_fwd, s_bwd = hgrn_bidir(pc, lb_all[0, l], lb_all[1, l], zero_state, zero_state)
        ox, _, _ = hgrn_bidir(px, lb_all[0, l], lb_all[1, l], s_fwd, s_bwd)
        yx = mixer_output(px, ox, w_pool[l], s_pool[l], g_hnorm[l], w_out[l], True)
        x = x + (ga1 * yx).astype(x.dtype)
        h2 = modulate(rmsnorm(x, g_ffn[l]), sh2, sc2)
        y2 = hier_moe(h2.reshape(b_ * n, d_), w_group[l], b_group[l], w_router[l], b_router[l], w1[l], w3[l], w2[l])
        x = x + (ga2 * y2.reshape(b_, n, d_)).astype(x.dtype)
        if l < DEPTH - 1:
            yc = mixer_output(pc, oc, w_pool[l], s_pool[l], g_hnorm[l], w_out[l], False)
            ctx = ctx + (cga1 * yc).astype(ctx.dtype)
            hc2 = modulate(rmsnorm(ctx, g_ffn[l]), csh2, csc2)
            yc2 = hier_moe(hc2.reshape(-1, d_), w_group[l], b_group[l], w_router[l], b_router[l], w1[l], w3[l], w2[l])
            ctx = ctx + (cga2 * yc2.reshape(ctx.shape)).astype(ctx.dtype)
    return rmsnorm(x, g_final)
```

```cpp
#include <hip/hip_runtime.h>
#include <hip/hip_cooperative_groups.h>
#include <cstdio>
#include <cstdint>
namespace cg = cooperative_groups;


#define LAS __attribute__((address_space(3)))
typedef unsigned short bf16_t;
typedef short bf16x8 __attribute__((ext_vector_type(8)));
typedef float f32x4 __attribute__((ext_vector_type(4)));
typedef float f32x2 __attribute__((ext_vector_type(2)));
typedef unsigned u32x4 __attribute__((ext_vector_type(4)));
typedef unsigned u32x2 __attribute__((ext_vector_type(2)));

constexpr int DM = 1024, NB = 4, SEQ = 8192, NTOK = NB * SEQ, CTXL = 256, NCTX = NB * CTXL, MROWS = NTOK + NCTX;
constexpr int DIN = 3072, HD = 128, NH = 4, NE = 32, DE = 512;
constexpr int SCL = 256, NSC = SEQ / SCL;
constexpr float EPS = 1e-6f;

constexpr size_t WS_CTL = 0;
constexpr size_t WS_MOD = 4096;
constexpr size_t WS_WINT = 131072;
constexpr size_t WS_WOUTT = WS_WINT + (size_t)DIN * DM * 2;
constexpr size_t WS_WPT = WS_WOUTT + (size_t)DM * DM * 2;
constexpr size_t WS_W13T = WS_WPT + (size_t)4 * 128 * 128 * 2;
constexpr size_t WS_W2T = WS_W13T + (size_t)NE * 1024 * 1024 * 2;
constexpr size_t WS_HX = WS_W2T + (size_t)NE * 1024 * 512 * 2;
constexpr size_t WS_P = WS_HX + (size_t)MROWS * DM * 2;
constexpr size_t WS_SL = WS_P + (size_t)MROWS * DIN * 2;
constexpr size_t WS_DL = WS_SL + (size_t)32 * (NSC + 1) * 128 * 128 * 4;
constexpr size_t WS_O = WS_DL + (size_t)32 * (NSC + 1) * 128 * 4;
constexpr size_t WS_BAR = WS_O + (size_t)2 * NTOK * 512 * 2;
constexpr size_t WS_CMAX = WS_BAR + 16384;
constexpr size_t WS_WINT8 = WS_CMAX + 16384;
constexpr size_t WS_SA = WS_WINT8 + (size_t)DIN * DM;
constexpr size_t WS_END = WS_SA + (size_t)MROWS * 4;
constexpr size_t WS_HXC = WS_HX + (size_t)MROWS * DM;
static_assert(WS_END <= (size_t)536870912, "workspace");
constexpr size_t WS_A2 = WS_HX;
constexpr size_t WS_H2 = WS_HX;
constexpr size_t WS_X1 = WS_P;
constexpr int MAXMT = NTOK * 2 / 256 + NE;
constexpr size_t WS_HH = WS_X1 + (size_t)NTOK * DM * 2;
constexpr size_t WS_GATE = WS_HH + (size_t)MAXMT * 256 * DE * 2;
constexpr size_t WS_INV = WS_GATE + (size_t)NTOK * 2 * 4;
constexpr size_t WS_P_USED_END = WS_INV + (size_t)NE * NTOK * 4;
constexpr size_t WS_Y = WS_SL;
static_assert(WS_P_USED_END <= WS_SL, "alias overflow P");
static_assert(WS_Y + (size_t)NTOK * 2 * DM * 2 <= WS_BAR, "alias overflow Y");

constexpr int LDS_GEMM = 131072;
constexpr int LDS_TAB = 159744;
constexpr int LDS_BYTES = 163840;

struct Params {
    const float *x, *c, *ctx, *c_ctx, *w_ada, *b_ada, *g_mix, *g_ffn, *w_in, *w_pool, *s_pool, *lb_logits, *g_hnorm, *w_out;
    const float *w_group, *b_group, *w_router, *b_router, *w1, *w3, *w2, *g_final;
    float* out; unsigned char* ws;
    unsigned phases, pad;
};

__device__ __forceinline__ size_t p_off(int cb, int row) { return ((size_t)cb * MROWS + (size_t)row) * 128; }
typedef int v8i32 __attribute__((ext_vector_type(8)));
typedef int v4i32 __attribute__((ext_vector_type(4)));
__device__ __forceinline__ float clamp_fp8(float x) { return fminf(fmaxf(x, -448.0f), 448.0f); }
__device__ __forceinline__ unsigned pk4_fp8(float a, float b, float c, float d) {
    int w = 0; w = __builtin_amdgcn_cvt_pk_fp8_f32(clamp_fp8(a), clamp_fp8(b), w, false); w = __builtin_amdgcn_cvt_pk_fp8_f32(clamp_fp8(c), clamp_fp8(d), w, true); return (unsigned)w; }
constexpr float W8_SCALE = 32.0f, W8_INV = 1.0f / 32.0f;
#define NT_LD(ptr) __builtin_nontemporal_load(ptr)
#define NT_ST(val, ptr) __builtin_nontemporal_store(val, ptr)
__device__ __forceinline__ float bf2f(unsigned b) { return __uint_as_float(b << 16); }
typedef __bf16 bf16v2 __attribute__((ext_vector_type(2)));
__device__ __forceinline__ unsigned cvt_pk_bf16(float lo, float hi) { f32x2 v = {lo, hi}; bf16v2 b = __builtin_convertvector(v, bf16v2); return __builtin_bit_cast(unsigned, b); }
__device__ __forceinline__ float wave_max(float v) {
#pragma unroll
    for (int o = 1; o < 64; o <<= 1) v = fmaxf(v, __shfl_xor(v, o));
    return v;
}
__device__ __forceinline__ unsigned pk4_i8(float a, float b, float c, float d) {
    const int i0 = (int)rintf(a), i1 = (int)rintf(b), i2 = (int)rintf(c), i3 = (int)rintf(d);
    return (unsigned)(i0 & 255) | ((unsigned)(i1 & 255) << 8) | ((unsigned)(i2 & 255) << 16) | ((unsigned)i3 << 24);
}
__device__ __forceinline__ float wave_sum(float v) {
#pragma unroll
    for (int o = 1; o < 64; o <<= 1) v += __shfl_xor(v, o);
    return v;
}
__device__ __forceinline__ float fast_exp(float x) { return __builtin_amdgcn_exp2f(x * 1.44269504089f); }
__device__ __forceinline__ float fast_log(float x) { return __builtin_amdgcn_logf(x) * 0.69314718056f; }
__device__ __forceinline__ float sigmoid_f(float z) { return __builtin_amdgcn_rcpf(1.0f + fast_exp(-z)); }
__device__ __forceinline__ float silu_f(float z) { return z * sigmoid_f(z); }

namespace pg8 {
constexpr int BM = 256, BK = 64, HALF = 128, HTB = HALF * BK * 2, NXCD = 8, WGM = 8;
__device__ __forceinline__ int lds_byte(int r, int c) { const int st = (r >> 4) * 2 + (c >> 5), rr = r & 15, cc = c & 31, ob = rr * 64 + cc * 2; return st * 1024 + (ob ^ (((ob >> 9) & 1) << 5)); }
__device__ __forceinline__ void stage_rc(int b, int& R, int& C) { const int st = b / 1024, sb = b % 1024, swz = sb ^ (((sb >> 9) & 1) << 5); R = (st >> 1) * 16 + swz / 64; C = (st & 1) * 32 + (swz % 64) / 2; }
__device__ __forceinline__ int perm32(int rho) { const int n = rho >> 4, i = rho & 15; return 8 * (i >> 2) + 4 * n + (i & 3); }

struct Unit { int pm, pn, e, aux; };

__device__ __forceinline__ void static_map(int L, int nM, int nN, int& pm, int& pn) {
    const int nwg = nM * nN; int wgid = L;
    { const int q = nwg / NXCD, r = nwg % NXCD, xcd = wgid % NXCD, off = wgid / NXCD; wgid = (xcd < r ? xcd * (q + 1) : r * (q + 1) + (xcd - r) * q) + off; }
    const int nig = WGM * nN, gid = wgid / nig, fm = gid * WGM, gsz = (nM - fm) < WGM ? (nM - fm) : WGM;
    pm = fm + ((wgid % nig) % gsz); pn = (wgid % nig) / gsz;
}

template <class Epi, class Sched>
__device__ __forceinline__ void gemm_phase(LAS unsigned char* lds, const int K, const Sched& S, const Epi& E) {
    const int tid = threadIdx.x, wid = __builtin_amdgcn_readfirstlane(tid >> 6), lane = tid & 63, wr = wid >> 2, wc = wid & 3, fr = lane & 15, fq = lane >> 4;
    const int nt = K / BK;
    int sR[2], sC[2]; unsigned voffB[2];
#pragma unroll
    for (int i = 0; i < 2; ++i) { int R, C; stage_rc(tid * 16 + i * 8192, R, C); sR[i] = R; sC[i] = C; const int Rb = Epi::PERM ? ((R & ~31) + perm32(R & 31)) : R; voffB[i] = (unsigned)(Rb * K + C) * 2u; }
    const size_t kstep = (size_t)(BK * 2);
    const size_t hstep = (size_t)HALF * K * 2;
    const unsigned ldsw = (unsigned)wid * 1024u;
    const int aoff = lds_byte(wr * 64 + fr, fq * 8), boff = lds_byte(wc * 32 + fr, fq * 8);
#define PG8_SA(b, h) (((b) * 2 + (h)) * HTB)
#define PG8_SB(b, h) ((4 + (b) * 2 + (h)) * HTB)
#define PG8_STAGE(bufoff, gbase, voff) do { _Pragma("unroll") for (int _i = 0; _i < 2; ++_i) \
        __builtin_amdgcn_global_load_lds((const unsigned*)((const char*)(gbase) + (voff)[_i]), (LAS unsigned*)(lds + (bufoff) + ldsw + _i * 8192), 16, 0, 0); } while (0)
#define PG8_LD2(base_) __builtin_shufflevector(*(const LAS v4i32*)(base_), *(const LAS v4i32*)((base_) + 1024), 0, 1, 2, 3, 4, 5, 6, 7)
#define PG8_LDA(dst, b, h) do { if constexpr (Sched::FP8) { _Pragma("unroll") for (int m = 0; m < 4; ++m) dst##8[m] = PG8_LD2(lds + PG8_SA(b, h) + aoff + m * 2048); } \
        else { _Pragma("unroll") for (int m = 0; m < 4; ++m) _Pragma("unroll") for (int k = 0; k < 2; ++k) dst[m][k] = *(const LAS bf16x8*)(lds + PG8_SA(b, h) + aoff + m * 2048 + k * 1024); } } while (0)
#define PG8_LDB(dst, b, h) do { if constexpr (Sched::FP8) { _Pragma("unroll") for (int n = 0; n < 2; ++n) dst##8[n] = PG8_LD2(lds + PG8_SB(b, h) + boff + n * 2048); } \
        else { _Pragma("unroll") for (int n = 0; n < 2; ++n) _Pragma("unroll") for (int k = 0; k < 2; ++k) dst[n][k] = *(const LAS bf16x8*)(lds + PG8_SB(b, h) + boff + n * 2048 + k * 1024); } } while (0)
#define PG8_MMA(ai, bj, At, Bt) do { __builtin_amdgcn_s_setprio(1); _Pragma("unroll") for (int m = 0; m < 4; ++m) _Pragma("unroll") for (int n = 0; n < 2; ++n) { \
        if constexpr (Sched::FP8) asm volatile("v_mfma_scale_f32_16x16x128_f8f6f4 %0, %1, %2, %0, %3, %3 op_sel_hi:[0,0,0]" : "+v"(acc[ai][bj][m][n]) : "v"(Bt##8[n]), "v"(At##8[m]), "v"(mxscale)); \
        else if constexpr (Sched::I8) { _Pragma("unroll") for (int k = 0; k < 2; ++k) acc[ai][bj][m][n] = __builtin_bit_cast(f32x4, __builtin_amdgcn_mfma_i32_16x16x64_i8( \
                __builtin_bit_cast(v4i32, Bt[n][k]), __builtin_bit_cast(v4i32, At[m][k]), __builtin_bit_cast(v4i32, acc[ai][bj][m][n]), 0, 0, 0)); } \
        else { _Pragma("unroll") for (int k = 0; k < 2; ++k) acc[ai][bj][m][n] = __builtin_amdgcn_mfma_f32_16x16x32_bf16(Bt[n][k], At[m][k], acc[ai][bj][m][n], 0, 0, 0); } } \
        __builtin_amdgcn_s_setprio(0); } while (0)
#define PG8_WAIT_V(n) asm volatile("s_waitcnt vmcnt(" #n ")" ::: "memory")
#define PG8_WAIT_L(n) asm volatile("s_waitcnt lgkmcnt(" #n ")" ::: "memory")
#define PG8_BAR __builtin_amdgcn_s_barrier()
#define PG8_SCHED __builtin_amdgcn_sched_barrier(0)
    Unit cur, nxt; int ui = 0;
    if (!S.next(0, cur)) return;
    f32x4 acc[2][2][4][2];
#pragma unroll
    for (int a = 0; a < 2; ++a)
#pragma unroll
        for (int b = 0; b < 2; ++b)
#pragma unroll
            for (int m = 0; m < 4; ++m)
#pragma unroll
                for (int n = 0; n < 2; ++n) acc[a][b][m][n] = (f32x4){0.f, 0.f, 0.f, 0.f};
    bf16x8 At[4][2], B0[2][2], B1[2][2]; v8i32 At8[4], B08[2], B18[2];
    const int mxscale = 0x7F7F7F7F;
    unsigned voA[2][2], voN[2][2];
    S.a_off(cur, sR, sC, voA);
    const char* cA = S.a_base(cur); const char* cB = S.b_base(cur);
    PG8_STAGE(PG8_SB(0, 0), cB, voffB); PG8_STAGE(PG8_SA(0, 0), cA, voA[0]); PG8_STAGE(PG8_SB(0, 1), cB + hstep, voffB); PG8_STAGE(PG8_SA(0, 1), cA, voA[1]);
    if (wr == 1) PG8_BAR;
    PG8_WAIT_V(4); PG8_BAR;
    PG8_STAGE(PG8_SB(1, 0), cB + kstep, voffB); PG8_STAGE(PG8_SA(1, 0), cA + kstep, voA[0]); PG8_STAGE(PG8_SB(1, 1), cB + hstep + kstep, voffB);
    PG8_WAIT_V(6); PG8_BAR;
    for (;;) {
        E.prefetch(cur, ui, wid, lane);
        const bool has_next = S.next(ui + 1, nxt);
        const char* nA = has_next ? S.a_base(nxt) : cA; const char* nB = has_next ? S.b_base(nxt) : cB;
        unsigned rawN[2][2] = {{0u, 0u}, {0u, 0u}};
        if (Sched::DYN_AOFF) { if (has_next) S.a_raw(nxt, sR, rawN); }
#pragma unroll 1
        for (int t = 0; t < nt; t += 2) {
            const bool last = (t == nt - 2);
            const char* a1 = cA + (size_t)(t + 1) * kstep;
            const char* a2 = last ? nA : cA + (size_t)(t + 2) * kstep; const char* b2 = last ? nB : cB + (size_t)(t + 2) * kstep;
            const char* a3 = a2 + kstep; const char* b3 = b2 + kstep;
            unsigned v2[2][2];
#pragma unroll
            for (int h = 0; h < 2; ++h)
#pragma unroll
                for (int i = 0; i < 2; ++i) v2[h][i] = voA[h][i];
            if (Sched::DYN_AOFF && last) {
                asm volatile("" : "+v"(rawN[0][0]));
#pragma unroll
                for (int h = 0; h < 2; ++h)
#pragma unroll
                    for (int i = 0; i < 2; ++i) { voN[h][i] = has_next ? S.a_fin(rawN[h][i], sC[i]) : voA[h][i]; v2[h][i] = voN[h][i]; }
            }
            PG8_LDB(B0, 0, 0); PG8_SCHED; PG8_LDA(At, 0, 0); PG8_STAGE(PG8_SA(1, 1), a1, voA[1]);
            PG8_WAIT_L(8); PG8_BAR; PG8_WAIT_L(0); PG8_MMA(0, 0, At, B0); PG8_BAR; PG8_SCHED;
            PG8_LDB(B1, 0, 1); PG8_STAGE(PG8_SB(0, 0), b2, voffB);
            PG8_BAR; PG8_WAIT_L(0); PG8_MMA(0, 1, At, B1); PG8_BAR;
            PG8_LDA(At, 0, 1); PG8_STAGE(PG8_SA(0, 0), a2, v2[0]);
            PG8_BAR; PG8_WAIT_L(0); PG8_MMA(1, 0, At, B0); PG8_BAR; PG8_SCHED;
            PG8_STAGE(PG8_SB(0, 1), b2 + hstep, voffB);
            PG8_WAIT_V(6); PG8_BAR; PG8_MMA(1, 1, At, B1); PG8_BAR;
            PG8_LDB(B0, 1, 0); PG8_SCHED; PG8_LDA(At, 1, 0); PG8_STAGE(PG8_SA(0, 1), a2, v2[1]);
            PG8_WAIT_L(8); PG8_BAR; PG8_WAIT_L(0); PG8_MMA(0, 0, At, B0); PG8_BAR; PG8_SCHED;
            PG8_LDB(B1, 1, 1); PG8_STAGE(PG8_SB(1, 0), b3, voffB);
            PG8_BAR; PG8_WAIT_L(0); PG8_MMA(0, 1, At, B1); PG8_BAR;
            PG8_LDA(At, 1, 1); PG8_STAGE(PG8_SA(1, 0), a3, v2[0]);
            PG8_BAR; PG8_WAIT_L(0); PG8_MMA(1, 0, At, B0); PG8_BAR; PG8_SCHED;
            PG8_STAGE(PG8_SB(1, 1), b3 + hstep, voffB);
            PG8_WAIT_V(6); PG8_BAR; PG8_MMA(1, 1, At, B1); PG8_BAR;
        }
        if constexpr (Sched::FP8) asm volatile("s_nop 15\n\ts_nop 15\n\ts_nop 7" ::: "memory");
        E(acc, cur, ui, wr, wc, fr, fq);
        if (!has_next) break;
#pragma unroll
        for (int a = 0; a < 2; ++a)
#pragma unroll
            for (int b = 0; b < 2; ++b)
#pragma unroll
                for (int m = 0; m < 4; ++m)
#pragma unroll
                    for (int n = 0; n < 2; ++n) acc[a][b][m][n] = (f32x4){0.f, 0.f, 0.f, 0.f};
        cur = nxt; cA = nA; cB = nB; ++ui;
        if (Sched::DYN_AOFF) {
#pragma unroll
            for (int h = 0; h < 2; ++h)
#pragma unroll
                for (int i = 0; i < 2; ++i) voA[h][i] = voN[h][i];
        }
    }
    PG8_WAIT_V(0);
    if (wr == 0) PG8_BAR;
    PG8_BAR;
#undef PG8_SA
#undef PG8_SB
#undef PG8_STAGE
#undef PG8_LDA
#undef PG8_LD2
#undef PG8_LDB
#undef PG8_MMA
#undef PG8_WAIT_V
#undef PG8_WAIT_L
#undef PG8_BAR
#undef PG8_SCHED
}
}
using pg8::Unit;

template <bool INT8>
struct SchedDenseT {
    static constexpr bool DYN_AOFF = false, FP8 = false, I8 = INT8;
    const char* A; const char* Bt; int K, nM, nN, G, c, nextra, ex_pm0, ex_pn0, ex_nn;
    __device__ __forceinline__ bool next(int i, Unit& u) const {
        const int L = i * G + c; const int nwg = nM * nN;
        if (L < nwg) { int pm, pn; pg8::static_map(L, nM, nN, pm, pn); u.pm = pm; u.pn = pn; u.e = 0; u.aux = 0; return true; }
        const int j = L - nwg; if (j >= nextra) return false;
        u.pm = ex_pm0 + j / ex_nn; u.pn = ex_pn0 + j % ex_nn; u.e = 0; u.aux = 0; return true;
    }
    __device__ __forceinline__ const char* a_base(const Unit& u) const { return A + (size_t)u.pm * 256 * K * 2; }
    __device__ __forceinline__ const char* b_base(const Unit& u) const { return Bt + (size_t)u.pn * 256 * K * 2; }
    __device__ __forceinline__ void a_raw(const Unit&, const int (&)[2], unsigned (&)[2][2]) const {}
    __device__ __forceinline__ unsigned a_fin(unsigned, int) const { return 0u; }
    __device__ __forceinline__ void a_off(const Unit&, const int (&sR)[2], const int (&sC)[2], unsigned (&vo)[2][2]) const {
#pragma unroll
        for (int h = 0; h < 2; ++h)
#pragma unroll
            for (int i = 0; i < 2; ++i) vo[h][i] = (unsigned)((h * 128 + sR[i]) * K + sC[i]) * 2u;
    }
};
template <bool GATHER>
struct SchedMoE {
    static constexpr bool DYN_AOFF = GATHER, FP8 = true, I8 = false;
    const char* A; const char* W; size_t wstride; int K, G, c; LAS const int* tab; const int* inv;
    int i_lo, i_hi;
    int l_first, l_count, l_stride;
    unsigned* dep; int dep_lo;
    __device__ __forceinline__ bool next(int i, Unit& u) const {
        const int ci = c >> 3; int mt, pn;
        if (i_hi < 0) { if (i >= l_count) return false; const int idx = l_first + i * l_stride; mt = idx >> 2; pn = idx & 3; }
        else { const int ii = i + i_lo; if (ii >= i_hi) return false; mt = ii * (G >> 2) + (c & 7) * (G >> 5) + (ci >> 2); pn = ci & 3; }
        const int total = tab[32];
        if (mt >= total) return false;
        if (!GATHER && i_hi < 0 && mt >= dep_lo) {
            unsigned* d = dep + 8 * (mt - dep_lo) + 1; unsigned sp = 0u;
            while (__hip_atomic_load(d, __ATOMIC_RELAXED, __HIP_MEMORY_SCOPE_AGENT) < 4u) { __builtin_amdgcn_s_sleep(2); if (++sp > (1u << 22)) break; }
            __builtin_amdgcn_fence(__ATOMIC_ACQUIRE, "agent");
        }
        const int e = ((LAS const unsigned char*)tab)[384 + mt];
        u.pm = __builtin_amdgcn_readfirstlane(mt); u.pn = __builtin_amdgcn_readfirstlane(pn); u.e = __builtin_amdgcn_readfirstlane(e); u.aux = __builtin_amdgcn_readfirstlane(mt - tab[e]);
        return true;
    }
    __device__ __forceinline__ const char* a_base(const Unit& u) const { return GATHER ? A : A + (size_t)u.pm * 256 * K * 2; }
    __device__ __forceinline__ const char* b_base(const Unit& u) const { return W + (size_t)u.e * wstride + (size_t)u.pn * 256 * K * 2; }
    __device__ __forceinline__ void a_raw(const Unit& u, const int (&sR)[2], unsigned (&raw)[2][2]) const {
        const int cnt = tab[64 + u.e];
#pragma unroll
        for (int h = 0; h < 2; ++h)
#pragma unroll
            for (int i = 0; i < 2; ++i) { const int idx = u.aux * 256 + h * 128 + sR[i]; unsigned r = 0u; if (idx < cnt) r = (unsigned)inv[(size_t)u.e * NTOK + idx]; raw[h][i] = r; }
    }
    __device__ __forceinline__ unsigned a_fin(unsigned r, int sc) const { return ((r & 0xffffu) >> 1) * (unsigned)(K * 2) + (unsigned)sc * 2u; }
    __device__ __forceinline__ void a_off(const Unit& u, const int (&sR)[2], const int (&sC)[2], unsigned (&vo)[2][2]) const {
        if (GATHER) {
            const int cnt = tab[64 + u.e];
#pragma unroll
            for (int h = 0; h < 2; ++h)
#pragma unroll
                for (int i = 0; i < 2; ++i) {
                    const int idx = u.aux * 256 + h * 128 + sR[i];
                    int slot = 0; if (idx < cnt) slot = inv[(size_t)u.e * NTOK + idx] & 0xffff;
                    vo[h][i] = (unsigned)(slot >> 1) * (unsigned)(K * 2) + (unsigned)sC[i] * 2u;
                }
        } else {
#pragma unroll
            for (int h = 0; h < 2; ++h)
#pragma unroll
                for (int i = 0; i < 2; ++i) vo[h][i] = (unsigned)((h * 128 + sR[i]) * K + sC[i]) * 2u;
        }
    }
};

template <bool I8>
struct EpiPT {
    static constexpr bool PERM = true;
    bf16_t* P; const float* lbl; const float* sa; const float* cmax;
    LAS const float* lcm; LAS const float* llb;
    LAS float* lrs;
    __device__ __forceinline__ void prefetch(const Unit& u, int ui, int wid, int lane) const {
        if constexpr (I8) { if (wid < 4) __builtin_amdgcn_global_load_lds((const unsigned*)(sa + u.pm * 256 + wid * 64 + lane), (LAS unsigned*)(lrs + (ui & 1) * 256 + wid * 64), 4, 0, 0); }
    }
    template <int ACT>
    __device__ __forceinline__ void body(const f32x4 (&acc)[2][2][4][2], const Unit& u, int ui, int wr, int wc, int fr, int fq) const {
        const int row0 = u.pm * 256 + wr * 64 + fr;
        float rs[8];
        if constexpr (I8) {
#pragma unroll
            for (int i = 0; i < 8; ++i) rs[i] = lrs[(ui & 1) * 256 + wr * 64 + fr + (i >> 2) * 128 + (i & 3) * 16] * (1.0f / 127.0f);
        }
#pragma unroll
        for (int bj = 0; bj < 2; ++bj) {
            const int col0 = u.pn * 256 + bj * 128 + wc * 32 + 8 * fq;
            float lb[8], cs[8];
#pragma unroll
            for (int j = 0; j < 8; ++j) { lb[j] = 0.f; cs[j] = 1.0f; }
            if constexpr (I8) { const f32x4 c0 = *(LAS const f32x4*)(lcm + col0), c1 = *(LAS const f32x4*)(lcm + col0 + 4);
#pragma unroll
                for (int j = 0; j < 4; ++j) { cs[j] = c0[j]; cs[4 + j] = c1[j]; } }
            if constexpr (ACT == 2) {
                const int cc = col0 - 1536;
                if constexpr (I8) { const f32x4 b0 = *(LAS const f32x4*)(llb + cc), b1 = *(LAS const f32x4*)(llb + cc + 4);
#pragma unroll
                    for (int j = 0; j < 4; ++j) { lb[j] = b0[j]; lb[4 + j] = b1[j]; } }
                else { const int dir = cc >> 9, c2 = cc & 511;
#pragma unroll
                    for (int j = 0; j < 8; ++j) { const float l0 = lbl[dir * 1024 + c2 + j], l1 = lbl[dir * 1024 + 512 + c2 + j]; lb[j] = sigmoid_f(l0 - l1); } }
            }
#pragma unroll
            for (int ai = 0; ai < 2; ++ai)
#pragma unroll
                for (int m = 0; m < 4; ++m) {
                    float v[8];
#pragma unroll
                    for (int j = 0; j < 4; ++j) { v[j] = acc[ai][bj][m][0][j]; v[4 + j] = acc[ai][bj][m][1][j]; }
                    if constexpr (I8) {
                        const float r = rs[ai * 4 + m];
#pragma unroll
                        for (int j = 0; j < 8; ++j) v[j] = (float)__builtin_bit_cast(int, v[j]) * (r * cs[j]);
                    }
                    if constexpr (ACT == 1) {
#pragma unroll
                        for (int j = 0; j < 8; ++j) v[j] = silu_f(v[j]);
                    } else if constexpr (ACT == 2) {
#pragma unroll
                        for (int j = 0; j < 8; ++j) { const float f = lb[j] + (1.0f - lb[j]) * sigmoid_f(v[j]); v[j] = fast_log(f); }
                    }
                    u32x4 w; w.x = cvt_pk_bf16(v[0], v[1]); w.y = cvt_pk_bf16(v[2], v[3]); w.z = cvt_pk_bf16(v[4], v[5]); w.w = cvt_pk_bf16(v[6], v[7]);
                    *(u32x4*)(P + p_off(col0 >> 7, row0 + ai * 128 + m * 16) + (col0 & 127)) = w;
                }
        }
    }
    __device__ __forceinline__ void operator()(const f32x4 (&acc)[2][2][4][2], const Unit& u, int ui, int wr, int wc, int fr, int fq) const {
        const int type = u.pn >> 1;
        if (type == 1 || type == 5) body<1>(acc, u, ui, wr, wc, fr, fq);
        else if (type == 3 || type == 4) body<2>(acc, u, ui, wr, wc, fr, fq);
        else body<0>(acc, u, ui, wr, wc, fr, fq);
    }
};
struct EpiX1 {
    static constexpr bool PERM = true;
    __device__ __forceinline__ void prefetch(const Unit&, int, int, int) const {}
    LAS const float* lga; bf16_t* out;
    __device__ __forceinline__ void operator()(const f32x4 (&acc)[2][2][4][2], const Unit& u, int, int wr, int wc, int fr, int fq) const {
        const int row0 = u.pm * 256 + wr * 64 + fr;
        const int b = (u.pm * 256) / SEQ;
#pragma unroll
        for (int bj = 0; bj < 2; ++bj) {
            const int col0 = u.pn * 256 + bj * 128 + wc * 32 + 8 * fq;
            const f32x4 g0 = *(LAS const f32x4*)(lga + b * 1024 + col0), g1 = *(LAS const f32x4*)(lga + b * 1024 + col0 + 4);
#pragma unroll
            for (int ai = 0; ai < 2; ++ai)
#pragma unroll
                for (int m = 0; m < 4; ++m) {
                    const f32x4 a0 = acc[ai][bj][m][0] * g0, a1 = acc[ai][bj][m][1] * g1;
                    u32x4 w; w.x = cvt_pk_bf16(a0[0], a0[1]); w.y = cvt_pk_bf16(a0[2], a0[3]); w.z = cvt_pk_bf16(a1[0], a1[1]); w.w = cvt_pk_bf16(a1[2], a1[3]);
                    *(u32x4*)(out + (size_t)(row0 + ai * 128 + m * 16) * DM + col0) = w;
                }
        }
    }
};
struct EpiH {
    static constexpr bool PERM = true;
    __device__ __forceinline__ void prefetch(const Unit&, int, int, int) const {}
    bf16_t* H;
    __device__ __forceinline__ void operator()(const f32x4 (&acc)[2][2][4][2], const Unit& u, int, int wr, int wc, int fr, int fq) const {
        const int row0 = u.pm * 256 + wr * 64 + fr, col0 = u.pn * 128 + wc * 32 + 8 * fq;
#pragma unroll
        for (int ai = 0; ai < 2; ++ai)
#pragma unroll
            for (int m = 0; m < 4; ++m) {
                float v[8];
#pragma unroll
                for (int j = 0; j < 4; ++j) { v[j] = silu_f(acc[ai][0][m][0][j] * W8_INV) * (acc[ai][1][m][0][j] * W8_INV); v[4 + j] = silu_f(acc[ai][0][m][1][j] * W8_INV) * (acc[ai][1][m][1][j] * W8_INV); }
                u32x2 w; w.x = pk4_fp8(v[0], v[1], v[2], v[3]); w.y = pk4_fp8(v[4], v[5], v[6], v[7]);
                *(u32x2*)((unsigned char*)H + (size_t)(row0 + ai * 128 + m * 16) * DE + col0) = w;
            }
    }
};
struct EpiY {
    static constexpr bool PERM = true;
    bf16_t* Y; const int* inv; LAS const int* tab;
    LAS unsigned* lpe;
    __device__ __forceinline__ void prefetch(const Unit& u, int ui, int wid, int lane) const {
        if (wid < 4) __builtin_amdgcn_global_load_lds((const unsigned*)(inv + (size_t)u.e * NTOK + u.aux * 256 + wid * 64 + lane), (LAS unsigned*)(lpe + (ui & 1) * 256 + wid * 64), 4, 0, 0);
    }
    __device__ __forceinline__ void operator()(const f32x4 (&acc)[2][2][4][2], const Unit& u, int ui, int wr, int wc, int fr, int fq) const {
        const int cnt = tab[64 + u.e];
        const int col0 = u.pn * 256 + wc * 32 + 8 * fq;
#pragma unroll
        for (int ai = 0; ai < 2; ++ai)
#pragma unroll
            for (int m = 0; m < 4; ++m) {
                const int ridx = wr * 64 + fr + ai * 128 + m * 16;
                if (u.aux * 256 + ridx < cnt) {
                    const unsigned ent = lpe[(ui & 1) * 256 + ridx];
                    const int slot = (int)(ent & 0xffffu); const float g = bf2f(ent >> 16) * W8_INV;
#pragma unroll
                    for (int bj = 0; bj < 2; ++bj) {
                        const f32x4 a0 = acc[ai][bj][m][0] * g, a1 = acc[ai][bj][m][1] * g;
                        u32x4 w; w.x = cvt_pk_bf16(a0[0], a0[1]); w.y = cvt_pk_bf16(a0[2], a0[3]); w.z = cvt_pk_bf16(a1[0], a1[1]); w.w = cvt_pk_bf16(a1[2], a1[3]);
                        *(u32x4*)(Y + (size_t)slot * DM + col0 + bj * 128) = w;
                    }
                }
            }
    }
};

__device__ __forceinline__ void transpose_item(const float* W, int Nsrc, int k0, int n0, bf16_t* WT, int ld, int row0, const float* scale, LAS float* scr, int lane, unsigned* cmax, bool wr_bf) {
#pragma unroll 8
    for (int i = 0; i < 32; ++i) { const int kk = 2 * i + (lane >> 5); scr[kk * 33 + (lane & 31)] = NT_LD(W + (size_t)(k0 + kk) * Nsrc + n0 + (lane & 31)); }
    asm volatile("s_waitcnt lgkmcnt(0)" ::: "memory");
    const int c = lane & 7;
#pragma unroll
    for (int j = 0; j < 4; ++j) {
        const int n = (lane >> 3) + 8 * j; const LAS float* s = scr + (8 * c) * 33 + n;
        const float sc = scale ? scale[n] : 1.0f;
        u32x4 o; o.x = cvt_pk_bf16(s[0 * 33] * sc, s[1 * 33] * sc); o.y = cvt_pk_bf16(s[2 * 33] * sc, s[3 * 33] * sc); o.z = cvt_pk_bf16(s[4 * 33] * sc, s[5 * 33] * sc); o.w = cvt_pk_bf16(s[6 * 33] * sc, s[7 * 33] * sc);
        if (wr_bf) *(u32x4*)(WT + (size_t)(row0 + n) * ld + k0 + 8 * c) = o;
        if (cmax) {
            float m = fmaxf(fmaxf(fmaxf(fabsf(s[0 * 33]), fabsf(s[1 * 33])), fmaxf(fabsf(s[2 * 33]), fabsf(s[3 * 33]))), fmaxf(fmaxf(fabsf(s[4 * 33]), fabsf(s[5 * 33])), fmaxf(fabsf(s[6 * 33]), fabsf(s[7 * 33]))));
            m = fmaxf(m, __shfl_xor(m, 1)); m = fmaxf(m, __shfl_xor(m, 2)); m = fmaxf(m, __shfl_xor(m, 4));
            if (c == 0) atomicMax(cmax + n0 + n, __float_as_uint(m));
        }
    }
    asm volatile("s_waitcnt lgkmcnt(0)" ::: "memory");
}

struct TItem { const float* W; bf16_t* WT; const float* scale; int Nsrc, k0, n0, ld, row0; int fp8; };
__device__ __forceinline__ void titem_emit(const TItem& T, const LAS float* q, int n, int c) {
    if (T.fp8 == 1) { u32x2 o8; o8.x = pk4_fp8(q[0 * 33] * W8_SCALE, q[1 * 33] * W8_SCALE, q[2 * 33] * W8_SCALE, q[3 * 33] * W8_SCALE); o8.y = pk4_fp8(q[4 * 33] * W8_SCALE, q[5 * 33] * W8_SCALE, q[6 * 33] * W8_SCALE, q[7 * 33] * W8_SCALE);
        NT_ST(o8, (u32x2*)((unsigned char*)T.WT + (size_t)(T.row0 + n) * T.ld + T.k0 + 8 * c)); }
    else if (T.fp8 == 2) { const float am = T.scale[n]; const float iv = am > 0.f ? 127.0f / am : 0.f;
        u32x2 o8; o8.x = pk4_i8(q[0 * 33] * iv, q[1 * 33] * iv, q[2 * 33] * iv, q[3 * 33] * iv); o8.y = pk4_i8(q[4 * 33] * iv, q[5 * 33] * iv, q[6 * 33] * iv, q[7 * 33] * iv);
        *(u32x2*)((unsigned char*)T.WT + (size_t)(T.row0 + n) * T.ld + T.k0 + 8 * c) = o8; }
    else { const float sc = T.scale ? T.scale[n] : 1.0f;
        u32x4 o; o.x = cvt_pk_bf16(q[0 * 33] * sc, q[1 * 33] * sc); o.y = cvt_pk_bf16(q[2 * 33] * sc, q[3 * 33] * sc); o.z = cvt_pk_bf16(q[4 * 33] * sc, q[5 * 33] * sc); o.w = cvt_pk_bf16(q[6 * 33] * sc, q[7 * 33] * sc);
        NT_ST(o, (u32x4*)(T.WT + (size_t)(T.row0 + n) * T.ld + T.k0 + 8 * c)); }
}
__device__ __forceinline__ void transpose_pair(const TItem& A, const TItem& B, bool hasB, LAS float* scr, int lane) {
    float va[32], vb[32];
#pragma unroll
    for (int i = 0; i < 32; ++i) { const int kk = 2 * i + (lane >> 5); va[i] = NT_LD(A.W + (size_t)(A.k0 + kk) * A.Nsrc + A.n0 + (lane & 31)); }
    if (hasB) {
#pragma unroll
        for (int i = 0; i < 32; ++i) { const int kk = 2 * i + (lane >> 5); vb[i] = NT_LD(B.W + (size_t)(B.k0 + kk) * B.Nsrc + B.n0 + (lane & 31)); }
    }
    const int c = lane & 7;
#pragma unroll
    for (int i = 0; i < 32; ++i) { const int kk = 2 * i + (lane >> 5); scr[kk * 33 + (lane & 31)] = va[i]; }
    asm volatile("s_waitcnt lgkmcnt(0)" ::: "memory");
#pragma unroll
    for (int j = 0; j < 4; ++j) {
        const int n = (lane >> 3) + 8 * j; const LAS float* q = scr + (8 * c) * 33 + n;
        titem_emit(A, q, n, c);
    }
    asm volatile("s_waitcnt lgkmcnt(0)" ::: "memory");
    if (hasB) {
#pragma unroll
        for (int i = 0; i < 32; ++i) { const int kk = 2 * i + (lane >> 5); scr[kk * 33 + (lane & 31)] = vb[i]; }
        asm volatile("s_waitcnt lgkmcnt(0)" ::: "memory");
#pragma unroll
        for (int j = 0; j < 4; ++j) {
            const int n = (lane >> 3) + 8 * j; const LAS float* q = scr + (8 * c) * 33 + n;
            titem_emit(B, q, n, c);
        }
        asm volatile("s_waitcnt lgkmcnt(0)" ::: "memory");
    }
}
constexpr int TI_W8 = 16 * 96, TI_O = 16 * 32, TI_13 = 2 * NE * 16 * 16, TI_2 = NE * 8 * 32, TI_P = 4 * 2 * 4, TI_ALL = TI_W8 + TI_O + TI_13 + TI_2 + TI_P;
__device__ __forceinline__ TItem decode_titem(const Params& p, int r) {
    TItem t; t.scale = nullptr; t.fp8 = 0;
    if (r < TI_W8) { const int kb = r / 96, nb = r % 96; t.W = p.w_in; t.Nsrc = DIN; t.k0 = kb * 64; t.n0 = nb * 32; t.WT = (bf16_t*)(p.ws + WS_WINT8); t.ld = DM; t.row0 = nb * 32; t.fp8 = 2; t.scale = (const float*)(p.ws + WS_CMAX) + nb * 32; return t; } r -= TI_W8;
    if (r < TI_O) { const int kb = r / 32, nb = r % 32; t.W = p.w_out; t.Nsrc = DM; t.k0 = kb * 64; t.n0 = nb * 32; t.WT = (bf16_t*)(p.ws + WS_WOUTT); t.ld = DM; t.row0 = nb * 32; return t; } r -= TI_O;
    if (r < TI_13) { const int which = r / (NE * 256); const int rr = r % (NE * 256); const int e = rr / 256, q = rr % 256, kb = q / 16, nb = q % 16; const int n0 = nb * 32;
        t.W = (which ? p.w3 : p.w1) + (size_t)e * DM * DE; t.Nsrc = DE; t.k0 = kb * 64; t.n0 = n0; t.WT = (bf16_t*)(p.ws + WS_W13T + (size_t)e * 1024 * 1024); t.ld = DM; t.fp8 = 1; t.row0 = (n0 >> 7) * 256 + which * 128 + (n0 & 127); return t; } r -= TI_13;
    if (r < TI_2) { const int e = r / 256, q = r % 256, kb = q / 32, nb = q % 32; t.W = p.w2 + (size_t)e * DE * DM; t.Nsrc = DM; t.k0 = kb * 64; t.n0 = nb * 32; t.WT = (bf16_t*)(p.ws + WS_W2T + (size_t)e * 1024 * 512); t.ld = DE; t.fp8 = 1; t.row0 = nb * 32; return t; } r -= TI_2;
    { const int g = r / 8, q = r % 8, kb = q / 4, nb = q % 4; t.W = p.w_pool + (size_t)g * 128 * 128; t.Nsrc = 128; t.k0 = kb * 64; t.n0 = nb * 32; t.WT = (bf16_t*)(p.ws + WS_WPT) + (size_t)g * 128 * 128; t.ld = 128; t.row0 = nb * 32; t.scale = p.s_pool + g * 128 + nb * 32; return t; }
}
template <int NR>
__device__ __forceinline__ void hx_rows(const Params& p, const float* mod, bf16_t* HX, int r0, int lane) {
    const float* xr0; int c;
    if (r0 < NTOK) { xr0 = p.x + (size_t)r0 * DM; c = r0 / SEQ; } else { xr0 = p.ctx + (size_t)(r0 - NTOK) * DM; c = 4; }
    f32x4 v[NR][4]; float s[NR];
#pragma unroll
    for (int u = 0; u < NR; ++u)
#pragma unroll
        for (int j = 0; j < 4; ++j) v[u][j] = NT_LD((const f32x4*)(xr0 + (size_t)u * DM + 4 * lane + 256 * j));
#pragma unroll
    for (int u = 0; u < NR; ++u) { s[u] = 0.f;
#pragma unroll
        for (int j = 0; j < 4; ++j) s[u] += (v[u][j][0] * v[u][j][0] + v[u][j][1] * v[u][j][1]) + (v[u][j][2] * v[u][j][2] + v[u][j][3] * v[u][j][3]); }
    float rstd[NR];
#pragma unroll
    for (int u = 0; u < NR; ++u) rstd[u] = rsqrtf(wave_sum(s[u]) * (1.0f / DM) + EPS);
#pragma unroll
    for (int j = 0; j < 4; ++j) {
        const int col = 4 * lane + 256 * j;
        const f32x4 g = *(const f32x4*)(p.g_mix + col), sh = *(const f32x4*)(mod + c * 6144 + col), scl = *(const f32x4*)(mod + c * 6144 + 1024 + col);
#pragma unroll
        for (int u = 0; u < NR; ++u) {
            f32x4 o;
#pragma unroll
            for (int q = 0; q < 4; ++q) o[q] = v[u][j][q] * rstd[u] * g[q] * (1.0f + scl[q]) + sh[q];
            u32x2 w; w.x = cvt_pk_bf16(o[0], o[1]); w.y = cvt_pk_bf16(o[2], o[3]);
            *(u32x2*)(HX + (size_t)(r0 + u) * DM + col) = w;
        }
    }
}
template <int NR>
__device__ __forceinline__ void hx_rows8(const Params& p, const float* mod, unsigned char* HX8, float* SA, int r0, int lane) {
    const float* xr0; int c;
    if (r0 < NTOK) { xr0 = p.x + (size_t)r0 * DM; c = r0 / SEQ; } else { xr0 = p.ctx + (size_t)(r0 - NTOK) * DM; c = 4; }
    f32x4 v[NR][4]; float s[NR];
#pragma unroll
    for (int u = 0; u < NR; ++u)
#pragma unroll
        for (int j = 0; j < 4; ++j) v[u][j] = NT_LD((const f32x4*)(xr0 + (size_t)u * DM + 4 * lane + 256 * j));
#pragma unroll
    for (int u = 0; u < NR; ++u) { s[u] = 0.f;
#pragma unroll
        for (int j = 0; j < 4; ++j) s[u] += (v[u][j][0] * v[u][j][0] + v[u][j][1] * v[u][j][1]) + (v[u][j][2] * v[u][j][2] + v[u][j][3] * v[u][j][3]); }
    float rstd[NR], am[NR];
#pragma unroll
    for (int u = 0; u < NR; ++u) { rstd[u] = rsqrtf(wave_sum(s[u]) * (1.0f / DM) + EPS); am[u] = 0.f; }
#pragma unroll
    for (int j = 0; j < 4; ++j) {
        const int col = 4 * lane + 256 * j;
        const f32x4 g = *(const f32x4*)(p.g_mix + col), sh = *(const f32x4*)(mod + c * 6144 + col), scl = *(const f32x4*)(mod + c * 6144 + 1024 + col);
#pragma unroll
        for (int u = 0; u < NR; ++u)
#pragma unroll
            for (int q = 0; q < 4; ++q) { const float o = v[u][j][q] * rstd[u] * g[q] * (1.0f + scl[q]) + sh[q]; v[u][j][q] = o; am[u] = fmaxf(am[u], fabsf(o)); }
    }
#pragma unroll
    for (int u = 0; u < NR; ++u) {
        const float a = wave_max(am[u]); const float iv = a > 0.f ? 127.0f / a : 0.f;
        if (lane == 0) SA[r0 + u] = a * (1.0f / 127.0f);
#pragma unroll
        for (int j = 0; j < 4; ++j) *(unsigned*)(HX8 + (size_t)(r0 + u) * DM + 4 * lane + 256 * j) = pk4_i8(v[u][j][0] * iv, v[u][j][1] * iv, v[u][j][2] * iv, v[u][j][3] * iv);
    }
}
struct SchedOne {
    static constexpr bool DYN_AOFF = false, FP8 = false, I8 = false;
    const char* A; const char* Bt; int K, pm, pn;
    __device__ __forceinline__ bool next(int i, Unit& u) const { if (i > 0) return false; u.pm = pm; u.pn = pn; u.e = 0; u.aux = 0; return true; }
    __device__ __forceinline__ const char* a_base(const Unit& u) const { return A + (size_t)u.pm * 256 * K * 2; }
    __device__ __forceinline__ const char* b_base(const Unit& u) const { return Bt + (size_t)u.pn * 256 * K * 2; }
    __device__ __forceinline__ void a_raw(const Unit&, const int (&)[2], unsigned (&)[2][2]) const {}
    __device__ __forceinline__ unsigned a_fin(unsigned, int) const { return 0u; }
    __device__ __forceinline__ void a_off(const Unit&, const int (&sR)[2], const int (&sC)[2], unsigned (&vo)[2][2]) const {
#pragma unroll
        for (int h = 0; h < 2; ++h)
#pragma unroll
            for (int i = 0; i < 2; ++i) vo[h][i] = (unsigned)((h * 128 + sR[i]) * K + sC[i]) * 2u;
    }
};

__device__ __forceinline__ void phase0(const Params& p, LAS unsigned char* lds) {
    const int tid = threadIdx.x, lane = tid & 63, wave = tid >> 6, G = gridDim.x;
    int* ctl = (int*)(p.ws + WS_CTL);
    if (blockIdx.x == 0) ctl[tid] = 0;
    float* mod = (float*)(p.ws + WS_MOD);
    LAS float* sc = (LAS float*)lds;
    LAS float* red = sc + 5 * 1024;
    bool did = false;
    for (int item = blockIdx.x; item < 192; item += G) {
        if (!did) {
            for (int i = tid; i < 5120; i += 512) { const int c = i >> 10, k = i & 1023; const float v = (c < 4) ? p.c[c * 1024 + k] : p.c_ctx[k]; sc[i] = v / (1.0f + expf(-v)); }
            __syncthreads(); did = true;
        }
        const int cl = tid & 31, kg = tid >> 5, col = item * 32 + cl;
        float a0 = 0.f, a1 = 0.f, a2 = 0.f, a3 = 0.f, a4 = 0.f;
#pragma unroll 32
        for (int kk = 0; kk < 64; ++kk) { const int k = kg * 64 + kk; const float w = NT_LD(p.w_ada + (size_t)k * 6144 + col);
            a0 += sc[k] * w; a1 += sc[1024 + k] * w; a2 += sc[2048 + k] * w; a3 += sc[3072 + k] * w; a4 += sc[4096 + k] * w; }
        red[(kg * 5 + 0) * 32 + cl] = a0; red[(kg * 5 + 1) * 32 + cl] = a1; red[(kg * 5 + 2) * 32 + cl] = a2; red[(kg * 5 + 3) * 32 + cl] = a3; red[(kg * 5 + 4) * 32 + cl] = a4;
        __syncthreads();
        if (tid < 160) { const int c = tid >> 5, l = tid & 31; float s = 0.f; for (int g = 0; g < 16; ++g) s += red[(g * 5 + c) * 32 + l]; mod[c * 6144 + item * 32 + l] = s + p.b_ada[item * 32 + l]; }
        __syncthreads();
    }
    __syncthreads();
    LAS float* scr = (LAS float*)(lds + 32768 + wave * 8448);
    const int gw = blockIdx.x * 8 + wave, NW = G * 8;
    bf16_t* WinT = (bf16_t*)(p.ws + WS_WINT);
    unsigned* cmax = (unsigned*)(p.ws + WS_CMAX);
    for (int it = gw; it < 16 * 96; it += NW) { const int kb = it / 96, nb = it % 96;
        transpose_item(p.w_in, DIN, kb * 64, nb * 32, WinT, DM, nb * 32, nullptr, scr, lane, cmax, nb >= 32 && nb < 80); }
}

__device__ __forceinline__ void phase1(const Params& p, LAS unsigned char* lds) {
    const int tid = threadIdx.x, lane = tid & 63, wave = tid >> 6, G = gridDim.x;
    const float* mod = (const float*)(p.ws + WS_MOD);
    bf16_t* HX = (bf16_t*)(p.ws + WS_HXC) - (size_t)NTOK * DM;
    unsigned char* HX8 = (unsigned char*)(p.ws + WS_HX); float* SA = (float*)(p.ws + WS_SA);
    const int nctx = (G > 48) ? 24 : 0;
    if ((int)blockIdx.x < nctx) {
        const int pm = NTOK / 256 + blockIdx.x / 6, pn = 4 + blockIdx.x % 6;
        for (int i = 0; i < 8; ++i) hx_rows<4>(p, mod, HX, pm * 256 + wave * 32 + 4 * i, lane);
        asm volatile("s_waitcnt vmcnt(0)" ::: "memory");
        __syncthreads();
        SchedOne S; S.A = (const char*)HX; S.Bt = (const char*)(p.ws + WS_WINT); S.K = DM; S.pm = pm; S.pn = pn;
        EpiPT<false> E; E.P = (bf16_t*)(p.ws + WS_P); E.lbl = p.lb_logits; E.sa = nullptr; E.cmax = nullptr; E.lcm = nullptr; E.llb = nullptr; E.lrs = nullptr; pg8::gemm_phase(lds, DM, S, E);
        return;
    }
    const int gw = (blockIdx.x - nctx) * 8 + wave, NW = (G - nctx) * 8;
    const int nrows = nctx ? NTOK : MROWS;
    for (int pr = gw; pr < nrows / 2; pr += NW) hx_rows8<2>(p, mod, HX8, SA, 2 * pr, lane);
    LAS float* scr = (LAS float*)(lds + wave * 8448);
    for (int it = gw; it < TI_ALL; it += 2 * NW) {
        const TItem A = decode_titem(p, it); const bool hasB = (it + NW) < TI_ALL; const TItem B = decode_titem(p, hasB ? it + NW : it);
        transpose_pair(A, B, hasB, scr, lane);
    }
}

__device__ __forceinline__ int scan_row(int b, int dir, int j, int t) {
    if (j < NSC) { const int pos = j * SCL + t; const int n = dir ? (SEQ - 1 - pos) : pos; return b * SEQ + n; }
    const int n = dir ? (CTXL - 1 - t) : t; return NTOK + b * CTXL + n;
}
typedef short s16x4 __attribute__((ext_vector_type(4)));
__device__ __forceinline__ unsigned off_b(unsigned row, unsigned ch) { return 256u * row + 16u * (ch ^ (((row & 3u) << 2) | ((row >> 2) & 3u))); }
struct FragBase { unsigned rowb[4]; unsigned tr_row0, tr_row1, tr_y0, tr_y1; };
__device__ __forceinline__ FragBase make_frag_base(int lane) {
    FragBase F; const unsigned l15 = lane & 15, g4 = lane >> 4, q = l15 >> 2, pp = lane & 3;
    const unsigned y = g4 ^ (((l15 & 3u) << 2) | (l15 >> 2));
#pragma unroll
    for (int sI = 0; sI < 4; ++sI) F.rowb[sI] = 256u * l15 + ((64u * sI) ^ (16u * y));
    const unsigned x0 = ((q & 3u) << 2) | ((2u * g4) & 3u), x1 = ((q & 3u) << 2) | ((2u * g4 + 1u) & 3u);
    F.tr_y0 = 16u * (x0 ^ (pp >> 1)); F.tr_y1 = 16u * (x1 ^ (pp >> 1));
    F.tr_row0 = 256u * (8u * g4 + q) + 8u * (pp & 1u); F.tr_row1 = F.tr_row0 + 1024u;
    return F;
}
__device__ __forceinline__ bf16x8 row_frag(LAS unsigned char* tile, const FragBase& F, int rb, int sI) { return *(const LAS bf16x8*)(tile + F.rowb[sI] + 4096u * rb); }
__device__ __forceinline__ bf16x8 tr_frag(LAS unsigned char* tile, const FragBase& F, int c, int ks) {
    const s16x4 r0 = __builtin_amdgcn_ds_read_tr16_b64_v4i16((LAS s16x4*)(tile + (F.tr_row0 + ((32u * c) ^ F.tr_y0)) + 8192u * ks));
    const s16x4 r1 = __builtin_amdgcn_ds_read_tr16_b64_v4i16((LAS s16x4*)(tile + (F.tr_row1 + ((32u * c) ^ F.tr_y1)) + 8192u * ks));
    return __builtin_shufflevector(r0, r1, 0, 1, 2, 3, 4, 5, 6, 7);
}
__device__ __forceinline__ float clamp80(float x) { return fminf(fmaxf(x, -80.0f), 80.0f); }

constexpr int HG_OF = 92672;
template <int MODE>
__device__ __forceinline__ void hgrn_body(const Params& p, LAS unsigned char* lds, const int b, const int h, const int dir, const int j, const int lane, const int w) {
    constexpr bool OUT = (MODE != 0);
    const int g4 = lane >> 4, l15 = lane & 15;
    const FragBase FB = make_frag_base(lane);
    LAS unsigned char* QD = lds; LAS unsigned char* KD = lds + 16384; LAS unsigned char* VV = lds + 32768; LAS unsigned char* SP = lds + 49152; LAS unsigned char* PP = lds + 81920;
    LAS float* TOT = (LAS float*)(lds + 81920); LAS float* VEC = (LAS float*)(lds + 91136);
    LAS unsigned char* OF = lds + HG_OF; LAS float* RS = (LAS float*)(lds + LDS_TAB + 1024);
    const bf16_t* P = (const bf16_t*)(p.ws + WS_P);
    bf16_t* SL = (bf16_t*)(p.ws + WS_SL); float* DL = (float*)(p.ws + WS_DL);
    bf16_t* A2 = (bf16_t*)(p.ws + WS_A2);
    const int scan = (b * 4 + h) * 2 + dir;
    bf16_t* sl = SL + (size_t)(scan * (NSC + 1) + j) * 16384;
    f32x4 st[8];
#pragma unroll
    for (int di = 0; di < 8; ++di) {
        if (OUT) { const u32x2 u = *(const u32x2*)(sl + (size_t)(16 * di + l15) * 128 + 16 * w + 4 * g4); st[di] = (f32x4){bf2f(u.x & 0xffffu), bf2f(u.x >> 16), bf2f(u.y & 0xffffu), bf2f(u.y >> 16)}; }
        else st[di] = (f32x4){0.f, 0.f, 0.f, 0.f};
    }
    float lsum0 = 0.f, lsum1 = 0.f;
    f32x4 gh = (f32x4){0.f, 0.f, 0.f, 0.f};
    if (MODE == 2) gh = *(const f32x4*)(p.g_hnorm + 16 * w + 4 * g4);
    f32x4 oxk[4]; u32x2 gtk[4];
    unsigned lfw[8], vw[8], qw[8];
#define HG_LOAD(cc) do { _Pragma("unroll") for (int i = 0; i < 8; ++i) { \
            const int row_ = scan_row(b, dir, j, (cc) * 64 + 8 * w + i); \
            lfw[i] = NT_LD((const unsigned*)(P + p_off(12 + dir * 4 + h, row_) + 2 * lane)); vw[i] = NT_LD((const unsigned*)(P + p_off(8 + h, row_) + 2 * lane)); \
            if (OUT) qw[i] = NT_LD((const unsigned*)(P + p_off(4 + h, row_) + 2 * lane)); else qw[i] = 0u; } } while (0)
    HG_LOAD(0);
#pragma unroll 1
    for (int c = 0; c < SCL / 64; ++c) {
        float bl0[8], bl1[8]; float r0 = 0.f, r1 = 0.f;
#pragma unroll
        for (int i = 0; i < 8; ++i) { r0 += bf2f(lfw[i] & 0xffffu); r1 += bf2f(lfw[i] >> 16); bl0[i] = r0; bl1[i] = r1; }
        *(LAS f32x2*)(TOT + w * 128 + 2 * lane) = (f32x2){r0, r1};
        __syncthreads();
        float pre0 = 0.f, pre1 = 0.f, bm0 = 0.f, bm1 = 0.f, bt0 = 0.f, bt1 = 0.f;
#pragma unroll
        for (int ww = 0; ww < 8; ++ww) { const f32x2 tt = *(const LAS f32x2*)(TOT + ww * 128 + 2 * lane);
            if (ww < w) { pre0 += tt[0]; pre1 += tt[1]; } if (ww < 4) { bm0 += tt[0]; bm1 += tt[1]; } bt0 += tt[0]; bt1 += tt[1]; }
#pragma unroll
        for (int i = 0; i < 8; ++i) {
            const unsigned t = 8 * w + i; const unsigned a = off_b(t, (unsigned)(lane >> 2)) + 4u * (lane & 3);
            const float b0 = pre0 + bl0[i], b1 = pre1 + bl1[i];
            const float k0 = 1.0f - fast_exp(bf2f(lfw[i] & 0xffffu)), k1 = 1.0f - fast_exp(bf2f(lfw[i] >> 16));
            *(LAS unsigned*)(KD + a) = cvt_pk_bf16(k0 * fast_exp(clamp80(bm0 - b0)), k1 * fast_exp(clamp80(bm1 - b1)));
            *(LAS unsigned*)(VV + a) = vw[i];
            if (OUT) *(LAS unsigned*)(QD + a) = cvt_pk_bf16(bf2f(qw[i] & 0xffffu) * fast_exp(clamp80(b0 - bm0)), bf2f(qw[i] >> 16) * fast_exp(clamp80(b1 - bm1)));
        }
        if (w == 0) {
            *(LAS f32x2*)(VEC + 2 * lane) = (f32x2){fast_exp(bm0), fast_exp(bm1)};
            *(LAS f32x2*)(VEC + 128 + 2 * lane) = (f32x2){fast_exp(bt0), fast_exp(bt1)};
            *(LAS f32x2*)(VEC + 256 + 2 * lane) = (f32x2){fast_exp(bt0 - bm0), fast_exp(bt1 - bm1)};
        }
        lsum0 += bt0; lsum1 += bt1;
        __syncthreads();
        if (c + 1 < SCL / 64) HG_LOAD(c + 1);
        bf16x8 Vt[2];
        Vt[0] = tr_frag(VV, FB, w, 0); Vt[1] = tr_frag(VV, FB, w, 1);
        if (OUT) {
#pragma unroll
            for (int di = 0; di < 8; ++di) {
                const int d = 16 * di + l15; const float e = VEC[d];
                u32x2 o; o.x = cvt_pk_bf16(e * st[di][0], e * st[di][1]); o.y = cvt_pk_bf16(e * st[di][2], e * st[di][3]);
                *(LAS u32x2*)(SP + off_b((unsigned)d, (unsigned)(2 * w + (g4 >> 1))) + 8u * (g4 & 1)) = o;
            }
            const int ti = w >> 1;
#pragma unroll
            for (int sx = 0; sx < 2; ++sx) {
                const int si = 2 * (w & 1) + sx;
                f32x4 a = (f32x4){0.f, 0.f, 0.f, 0.f};
                if (si <= ti) {
#pragma unroll
                    for (int ks = 0; ks < 4; ++ks) a = __builtin_amdgcn_mfma_f32_16x16x32_bf16(row_frag(KD, FB, si, ks), row_frag(QD, FB, ti, ks), a, 0, 0, 0);
                }
                const int tt = 16 * ti + l15, s0 = 16 * si + 4 * g4;
                u32x2 o; o.x = cvt_pk_bf16(s0 + 0 <= tt ? a[0] : 0.f, s0 + 1 <= tt ? a[1] : 0.f); o.y = cvt_pk_bf16(s0 + 2 <= tt ? a[2] : 0.f, s0 + 3 <= tt ? a[3] : 0.f);
                *(LAS u32x2*)(PP + tt * 144 + s0 * 2) = o;
            }
            __syncthreads();
            bf16x8 St[4];
#pragma unroll
            for (int ks = 0; ks < 4; ++ks) St[ks] = tr_frag(SP, FB, w, ks);
#pragma unroll
            for (int ti2 = 0; ti2 < 4; ++ti2) {
                f32x4 oa = (f32x4){0.f, 0.f, 0.f, 0.f};
#pragma unroll
                for (int ks = 0; ks < 2; ++ks) { const bf16x8 pf = *(const LAS bf16x8*)(PP + (16 * ti2 + l15) * 144 + (32 * ks + 8 * g4) * 2); oa = __builtin_amdgcn_mfma_f32_16x16x32_bf16(Vt[ks], pf, oa, 0, 0, 0); }
#pragma unroll
                for (int ks = 0; ks < 4; ++ks) oa = __builtin_amdgcn_mfma_f32_16x16x32_bf16(St[ks], row_frag(QD, FB, ti2, ks), oa, 0, 0, 0);
                const int tpos = c * 64 + 16 * ti2 + l15;
                if (MODE == 1) {
                    const unsigned ta = (unsigned)tpos;
                    u32x2 o; o.x = cvt_pk_bf16(oa[0], oa[1]); o.y = cvt_pk_bf16(oa[2], oa[3]);
                    *(LAS u32x2*)(OF + ta * 256u + ((((unsigned)(4 * w + g4)) ^ (ta & 31u)) << 3)) = o;
                } else {
                    const unsigned ta = (unsigned)(SCL - 1 - tpos);
                    const u32x2 f = *(const LAS u32x2*)(OF + ta * 256u + ((((unsigned)(4 * w + g4)) ^ (ta & 31u)) << 3));
                    f32x4 ox; ox[0] = oa[0] + bf2f(f.x & 0xffffu); ox[1] = oa[1] + bf2f(f.x >> 16); ox[2] = oa[2] + bf2f(f.y & 0xffffu); ox[3] = oa[3] + bf2f(f.y >> 16);
                    float ss = (ox[0] * ox[0] + ox[1] * ox[1]) + (ox[2] * ox[2] + ox[3] * ox[3]);
                    ss += __shfl_xor(ss, 16); ss += __shfl_xor(ss, 32);
                    if (g4 == 0) RS[(16 * ti2 + l15) * 8 + w] = ss;
                    oxk[ti2] = ox;
                    const int row = scan_row(b, dir, j, tpos);
                    gtk[ti2] = NT_LD((const u32x2*)(P + p_off(20 + h, row) + 16 * w + 4 * g4));
                }
            }
        }
#pragma unroll
        for (int di = 0; di < 8; ++di) {
            f32x4 tmp = (f32x4){0.f, 0.f, 0.f, 0.f};
#pragma unroll
            for (int ks = 0; ks < 2; ++ks) tmp = __builtin_amdgcn_mfma_f32_16x16x32_bf16(Vt[ks], tr_frag(KD, FB, di, ks), tmp, 0, 0, 0);
            const int d = 16 * di + l15; const float e63 = VEC[128 + d], e63m = VEC[256 + d];
            st[di] = st[di] * e63 + tmp * e63m;
        }
        __syncthreads();
        if (MODE == 2) {
#pragma unroll
            for (int ti2 = 0; ti2 < 4; ++ti2) {
                const f32x4 ra = *(const LAS f32x4*)(RS + (16 * ti2 + l15) * 8), rb = *(const LAS f32x4*)(RS + (16 * ti2 + l15) * 8 + 4);
                const float tot = ((ra[0] + ra[1]) + (ra[2] + ra[3])) + ((rb[0] + rb[1]) + (rb[2] + rb[3]));
                const float rstd = rsqrtf(tot * (1.0f / HD) + EPS);
                const int row = scan_row(b, dir, j, c * 64 + 16 * ti2 + l15);
                const u32x2 gt = gtk[ti2]; const f32x4 ox = oxk[ti2];
                u32x2 o; o.x = cvt_pk_bf16(ox[0] * rstd * gh[0] * bf2f(gt.x & 0xffffu), ox[1] * rstd * gh[1] * bf2f(gt.x >> 16));
                o.y = cvt_pk_bf16(ox[2] * rstd * gh[2] * bf2f(gt.y & 0xffffu), ox[3] * rstd * gh[3] * bf2f(gt.y >> 16));
                *(u32x2*)(A2 + (size_t)row * DM + 512 + h * 128 + 16 * w + 4 * g4) = o;
            }
        }
    }
#undef HG_LOAD
    if (!OUT) {
#pragma unroll
        for (int di = 0; di < 8; ++di) { u32x2 u; u.x = cvt_pk_bf16(st[di][0], st[di][1]); u.y = cvt_pk_bf16(st[di][2], st[di][3]); *(u32x2*)(sl + (size_t)(16 * di + l15) * 128 + 16 * w + 4 * g4) = u; }
        if (w == 0) { float* dl = DL + (size_t)(scan * (NSC + 1) + j) * 128; dl[2 * lane] = fast_exp(lsum0); dl[2 * lane + 1] = fast_exp(lsum1); }
    }
}
__device__ __forceinline__ void hgrn_pass1(const Params& p, LAS unsigned char* lds) {
    const int tid = threadIdx.x, lane = tid & 63, w = __builtin_amdgcn_readfirstlane(tid >> 6), G = gridDim.x;
    const int g4 = lane >> 4, l15 = lane & 15;
    const FragBase FB = make_frag_base(lane);
    LAS unsigned char* KD = lds; LAS unsigned char* VV = lds + 65536; LAS float* TOT = (LAS float*)(lds + 131072);
    const bf16_t* P = (const bf16_t*)(p.ws + WS_P);
    bf16_t* SL = (bf16_t*)(p.ws + WS_SL); float* DL = (float*)(p.ws + WS_DL);
    unsigned lfw[32], vw[32];
#define P1_LOAD(it_) do { const int jj_ = (it_) % NSC, scan_ = (it_) / NSC, dir_ = scan_ & 1, bh_ = scan_ >> 1, b_ = bh_ >> 2, h_ = bh_ & 3; const int j_ = (jj_ == NSC - 1) ? NSC : jj_; \
        _Pragma("unroll") for (int i = 0; i < 32; ++i) { const int row = scan_row(b_, dir_, j_, 32 * w + i); \
            lfw[i] = *(const unsigned*)(P + p_off(12 + dir_ * 4 + h_, row) + 2 * lane); vw[i] = *(const unsigned*)(P + p_off(8 + h_, row) + 2 * lane); } } while (0)
    if ((int)blockIdx.x < 32 * NSC) P1_LOAD(blockIdx.x);
    for (int item = blockIdx.x; item < 32 * NSC; item += G) {
        const int jj = item % NSC, scan = item / NSC;
        const int j = (jj == NSC - 1) ? NSC : jj;
        float r0 = 0.f, r1 = 0.f;
#pragma unroll
        for (int i = 0; i < 32; ++i) { r0 += bf2f(lfw[i] & 0xffffu); r1 += bf2f(lfw[i] >> 16); }
        *(LAS f32x2*)(TOT + w * 128 + 2 * lane) = (f32x2){r0, r1};
        __syncthreads();
        float pre0 = 0.f, pre1 = 0.f, bt0 = 0.f, bt1 = 0.f;
#pragma unroll
        for (int ww = 0; ww < 8; ++ww) { const f32x2 tt = *(const LAS f32x2*)(TOT + ww * 128 + 2 * lane); if (ww < w) { pre0 += tt[0]; pre1 += tt[1]; } bt0 += tt[0]; bt1 += tt[1]; }
#pragma unroll
        for (int i = 0; i < 32; ++i) {
            const unsigned t = 32 * w + i; const unsigned a = off_b(t, (unsigned)(lane >> 2)) + 4u * (lane & 3);
            const float l0 = bf2f(lfw[i] & 0xffffu), l1 = bf2f(lfw[i] >> 16);
            pre0 += l0; pre1 += l1;
            const float k0 = 1.0f - fast_exp(l0), k1 = 1.0f - fast_exp(l1);
            *(LAS unsigned*)(KD + a) = cvt_pk_bf16(k0 * fast_exp(fmaxf(bt0 - pre0, -80.0f)), k1 * fast_exp(fmaxf(bt1 - pre1, -80.0f)));
            *(LAS unsigned*)(VV + a) = vw[i];
        }
        __syncthreads();
        if (item + G < 32 * NSC) P1_LOAD(item + G);
        bf16x8 Vt[8];
#pragma unroll
        for (int ks = 0; ks < 8; ++ks) Vt[ks] = tr_frag(VV, FB, w, ks);
        bf16_t* sl = SL + (size_t)(scan * (NSC + 1) + j) * 16384;
#pragma unroll
        for (int di = 0; di < 8; ++di) {
            f32x4 acc = (f32x4){0.f, 0.f, 0.f, 0.f};
#pragma unroll
            for (int ks = 0; ks < 8; ++ks) acc = __builtin_amdgcn_mfma_f32_16x16x32_bf16(Vt[ks], tr_frag(KD, FB, di, ks), acc, 0, 0, 0);
            u32x2 u; u.x = cvt_pk_bf16(acc[0], acc[1]); u.y = cvt_pk_bf16(acc[2], acc[3]);
            *(u32x2*)(sl + (size_t)(16 * di + l15) * 128 + 16 * w + 4 * g4) = u;
        }
        if (w == 0) { float* dl = DL + (size_t)(scan * (NSC + 1) + j) * 128; dl[2 * lane] = fast_exp(bt0); dl[2 * lane + 1] = fast_exp(bt1); }
    }
#undef P1_LOAD
}
__device__ __forceinline__ void hgrn_pass3(const Params& p, LAS unsigned char* lds) {
    const int tid = threadIdx.x, lane = tid & 63, w = __builtin_amdgcn_readfirstlane(tid >> 6), G = gridDim.x;
    for (int item = blockIdx.x; item < 16 * NSC; item += G) {
        const int jt = item % NSC, bh = item / NSC, b = bh >> 2, h = bh & 3;
        hgrn_body<1>(p, lds, b, h, 0, jt, lane, w);
        hgrn_body<2>(p, lds, b, h, 1, NSC - 1 - jt, lane, w);
    }
}

__device__ __forceinline__ void hgrn_combine(const Params& p) {
    bf16_t* SL = (bf16_t*)(p.ws + WS_SL); const float* DL = (const float*)(p.ws + WS_DL);
    const size_t gtid = (size_t)blockIdx.x * 512 + threadIdx.x, gsz = (size_t)gridDim.x * 512;
    for (size_t e4 = gtid; e4 < (size_t)32 * 4096; e4 += gsz) {
        const int scan = (int)(e4 >> 12), dv = (int)(e4 & 4095) * 4, d = dv >> 7;
        bf16_t* base = SL + (size_t)scan * (NSC + 1) * 16384 + dv; const float* dl = DL + (size_t)scan * (NSC + 1) * 128 + d;
        u32x2 loc[NSC]; float dec[NSC];
#pragma unroll
        for (int j = 0; j < NSC - 1; ++j) { loc[j] = *(const u32x2*)(base + (size_t)j * 16384); dec[j] = dl[j * 128]; }
        const u32x2 s0 = *(const u32x2*)(base + (size_t)NSC * 16384);
        f32x4 S = (f32x4){bf2f(s0.x & 0xffffu), bf2f(s0.x >> 16), bf2f(s0.y & 0xffffu), bf2f(s0.y >> 16)};
#pragma unroll
        for (int j = 0; j < NSC; ++j) {
            u32x2 o; o.x = cvt_pk_bf16(S[0], S[1]); o.y = cvt_pk_bf16(S[2], S[3]); *(u32x2*)(base + (size_t)j * 16384) = o;
            if (j < NSC - 1) { const f32x4 L = (f32x4){bf2f(loc[j].x & 0xffffu), bf2f(loc[j].x >> 16), bf2f(loc[j].y & 0xffffu), bf2f(loc[j].y >> 16)}; S = S * dec[j] + L; }
        }
    }
}

__device__ __forceinline__ void phase_mix(const Params& p, LAS unsigned char* lds) {
    const int tid = threadIdx.x, lane = tid & 63, wave = tid >> 6, G = gridDim.x;
    const bf16_t* P = (const bf16_t*)(p.ws + WS_P); bf16_t* A2 = (bf16_t*)(p.ws + WS_A2);
    const bf16_t* WpT = (const bf16_t*)(p.ws + WS_WPT);
    LAS float* vs = (LAS float*)lds;
    LAS bf16_t* dA = (LAS bf16_t*)(lds + 2 * 64 * 132 * 4);
    const int mt = wave >> 1, nh = wave & 1, fr = lane & 15, fq = lane >> 4;
    for (int item = blockIdx.x; item < NB * 4 * 16; item += G) {
        const int g = item & 3, rb = (item >> 2) & 15, b = item >> 6;
        const int w = 2 << g, hw = w >> 1;
        bf16x8 bfr[4][4];
#pragma unroll
        for (int kk = 0; kk < 4; ++kk)
#pragma unroll
            for (int nf = 0; nf < 4; ++nf) bfr[kk][nf] = *(const bf16x8*)(WpT + (size_t)g * 16384 + (size_t)(64 * nh + nf * 16 + fr) * 128 + kk * 32 + fq * 8);
        const bf16_t* Pg = P + p_off(g, b * SEQ);
        float vsum[4][8];
        const int rfirst = rb * 8;
#pragma unroll
        for (int i = 0; i < 4; ++i) {
            const int st = i >> 1, q = tid + 512 * (i & 1), cc = q >> 4, ch = q & 15, r0 = rfirst + 4 * st;
#pragma unroll
            for (int k = 0; k < 8; ++k) vsum[i][k] = 0.f;
#pragma unroll 8
            for (int rr = max(r0 - hw, 0); rr < min(r0 + hw, 128); ++rr) {
                const u32x4 u = *(const u32x4*)(Pg + (size_t)(rr * 64 + cc) * 128 + ch * 8);
                vsum[i][0] += bf2f(u.x & 0xffffu); vsum[i][1] += bf2f(u.x >> 16); vsum[i][2] += bf2f(u.y & 0xffffu); vsum[i][3] += bf2f(u.y >> 16);
                vsum[i][4] += bf2f(u.z & 0xffffu); vsum[i][5] += bf2f(u.z >> 16); vsum[i][6] += bf2f(u.w & 0xffffu); vsum[i][7] += bf2f(u.w >> 16);
            }
        }
#pragma unroll 1
        for (int s4 = 0; s4 < 4; ++s4) {
            u32x4 cen[4], addv[4], subv[4];
#pragma unroll
            for (int i = 0; i < 4; ++i) {
                const int st = i >> 1, q = tid + 512 * (i & 1), cc = q >> 4, ch = q & 15, r = rfirst + 4 * st + s4;
                const bool hasadd = (r + hw) < 128, hassub = (r - hw) >= 0;
                cen[i] = *(const u32x4*)(Pg + (size_t)(r * 64 + cc) * 128 + ch * 8);
                addv[i] = hasadd ? *(const u32x4*)(Pg + (size_t)((r + hw) * 64 + cc) * 128 + ch * 8) : (u32x4){0u, 0u, 0u, 0u};
                subv[i] = hassub ? *(const u32x4*)(Pg + (size_t)((r - hw) * 64 + cc) * 128 + ch * 8) : (u32x4){0u, 0u, 0u, 0u};
#pragma unroll
                for (int k = 0; k < 8; ++k) vs[(st * 64 + cc) * 132 + ch * 8 + k] = vsum[i][k];
            }
            __syncthreads();
#pragma unroll
            for (int i = 0; i < 4; ++i) {
                const int st = i >> 1, q = tid + 512 * (i & 1), cc = q >> 4, ch = q & 15, r = rfirst + 4 * st + s4;
                const int nr = min(r + hw, 128) - max(r - hw, 0);
                const int c0 = max(cc - hw, 0), c1 = min(cc + hw, 64);
                float a[8];
#pragma unroll
                for (int k = 0; k < 8; ++k) a[k] = 0.f;
                for (int c2 = c0; c2 < c1; ++c2) {
#pragma unroll
                    for (int k = 0; k < 8; ++k) a[k] += vs[(st * 64 + c2) * 132 + ch * 8 + k];
                }
                const float inv = __builtin_amdgcn_rcpf((float)(nr * (c1 - c0)));
                const u32x4 u = cen[i];
                u32x4 o; o.x = cvt_pk_bf16(a[0] * inv - bf2f(u.x & 0xffffu), a[1] * inv - bf2f(u.x >> 16)); o.y = cvt_pk_bf16(a[2] * inv - bf2f(u.y & 0xffffu), a[3] * inv - bf2f(u.y >> 16));
                o.z = cvt_pk_bf16(a[4] * inv - bf2f(u.z & 0xffffu), a[5] * inv - bf2f(u.z >> 16)); o.w = cvt_pk_bf16(a[6] * inv - bf2f(u.w & 0xffffu), a[7] * inv - bf2f(u.w >> 16));
                *(LAS u32x4*)(dA + (st * 64 + cc) * 136 + ch * 8) = o;
                const u32x4 pa = addv[i], ps = subv[i];
                vsum[i][0] += bf2f(pa.x & 0xffffu) - bf2f(ps.x & 0xffffu); vsum[i][1] += bf2f(pa.x >> 16) - bf2f(ps.x >> 16);
                vsum[i][2] += bf2f(pa.y & 0xffffu) - bf2f(ps.y & 0xffffu); vsum[i][3] += bf2f(pa.y >> 16) - bf2f(ps.y >> 16);
                vsum[i][4] += bf2f(pa.z & 0xffffu) - bf2f(ps.z & 0xffffu); vsum[i][5] += bf2f(pa.z >> 16) - bf2f(ps.z >> 16);
                vsum[i][6] += bf2f(pa.w & 0xffffu) - bf2f(ps.w & 0xffffu); vsum[i][7] += bf2f(pa.w >> 16) - bf2f(ps.w >> 16);
            }
            __syncthreads();
#pragma unroll
            for (int st = 0; st < 2; ++st) {
                f32x4 acc[4];
#pragma unroll
                for (int nf = 0; nf < 4; ++nf) acc[nf] = (f32x4){0.f, 0.f, 0.f, 0.f};
#pragma unroll
                for (int kk = 0; kk < 4; ++kk) {
                    const bf16x8 af = *(const LAS bf16x8*)(dA + (st * 64 + 16 * mt + fr) * 136 + kk * 32 + fq * 8);
#pragma unroll
                    for (int nf = 0; nf < 4; ++nf) acc[nf] = __builtin_amdgcn_mfma_f32_16x16x32_bf16(bfr[kk][nf], af, acc[nf], 0, 0, 0);
                }
                const int r = rfirst + 4 * st + s4;
#pragma unroll
                for (int nf = 0; nf < 4; ++nf) {
                    u32x2 o; o.x = cvt_pk_bf16(acc[nf][0], acc[nf][1]); o.y = cvt_pk_bf16(acc[nf][2], acc[nf][3]);
                    *(u32x2*)(A2 + (size_t)(b * SEQ + r * 64 + 16 * mt + fr) * DM + g * 128 + 64 * nh + nf * 16 + 4 * fq) = o;
                }
            }
        }
        __syncthreads();
    }
}

constexpr int CNT_STRIDE = 16;
__device__ __forceinline__ float tr_reduce8(const float (&v)[8], int lane) {
    float r4[4], r2[2], r1;
    const bool h5 = (lane & 32) != 0, h4 = (lane & 16) != 0, h3 = (lane & 8) != 0;
#pragma unroll
    for (int i = 0; i < 4; ++i) { const float keep = h5 ? v[4 + i] : v[i], send = h5 ? v[i] : v[4 + i]; r4[i] = keep + __shfl_xor(send, 32); }
#pragma unroll
    for (int i = 0; i < 2; ++i) { const float keep = h4 ? r4[2 + i] : r4[i], send = h4 ? r4[i] : r4[2 + i]; r2[i] = keep + __shfl_xor(send, 16); }
    { const float keep = h3 ? r2[1] : r2[0], send = h3 ? r2[0] : r2[1]; r1 = keep + __shfl_xor(send, 8); }
    r1 += __shfl_xor(r1, 4); r1 += __shfl_xor(r1, 2); r1 += __shfl_xor(r1, 1);
    return r1;
}
__device__ __forceinline__ void phase_route(const Params& p, LAS unsigned char* lds) {
    const int tid = threadIdx.x, lane = tid & 63, wave = tid >> 6, G = gridDim.x;
    const float* mod = (const float*)(p.ws + WS_MOD);
    bf16_t* H2 = (bf16_t*)(p.ws + WS_H2); int* inv = (int*)(p.ws + WS_INV); int* cnt = (int*)(p.ws + WS_CTL);
    bf16_t* X1 = (bf16_t*)(p.ws + WS_X1);
    LAS f32x4* WR = (LAS f32x4*)lds;
    LAS int* hist = (LAS int*)(lds + LDS_TAB); LAS int* basee = hist + 32;
    for (int f = tid; f < 4 * 1024 * 2; f += 512) {
        const int half = f & 1, k = (f >> 1) & 1023, g = f >> 11;
        const int j = k >> 8, ln = (k & 255) >> 2, q = k & 3;
        WR[(((g * 4 + j) * 4 + q) * 2 + half) * 64 + ln] = *(const f32x4*)(p.w_router + (size_t)f * 4);
    }
    float wg[4][4][4];
#pragma unroll
    for (int j = 0; j < 4; ++j)
#pragma unroll
        for (int q = 0; q < 4; ++q) { const f32x4 t = *(const f32x4*)(p.w_group + (size_t)(256 * j + 4 * lane + q) * 4); wg[j][q][0] = t[0]; wg[j][q][1] = t[1]; wg[j][q][2] = t[2]; wg[j][q][3] = t[3]; }
    constexpr int TPB = 128;
    for (int blk = blockIdx.x; blk < NTOK / TPB; blk += G) {
        if (tid < 32) hist[tid] = 0;
        __syncthreads();
        LAS int* asg = (LAS int*)(lds + LDS_TAB + 1024) + wave * 64;
        f32x4 nx[2][4]; u32x2 ny[2][4];
        { const int tok0 = blk * TPB + wave * 16;
#pragma unroll
          for (int u = 0; u < 2; ++u)
#pragma unroll
            for (int j = 0; j < 4; ++j) { nx[u][j] = NT_LD((const f32x4*)(p.x + (size_t)(tok0 + u) * DM + 4 * lane + 256 * j)); ny[u][j] = *(const u32x2*)(X1 + (size_t)(tok0 + u) * DM + 4 * lane + 256 * j); } }
#pragma unroll 1
        for (int it = 0; it < 16; it += 2) {
            const int tok = blk * TPB + wave * 16 + it;
            const int b = tok / SEQ;
            f32x4 v[2][4]; u32x2 yv[2][4]; float s[2] = {0.f, 0.f};
#pragma unroll
            for (int u = 0; u < 2; ++u)
#pragma unroll
                for (int j = 0; j < 4; ++j) { v[u][j] = nx[u][j]; yv[u][j] = ny[u][j]; }
            if (it < 14) {
#pragma unroll
                for (int u = 0; u < 2; ++u)
#pragma unroll
                    for (int j = 0; j < 4; ++j) { nx[u][j] = NT_LD((const f32x4*)(p.x + (size_t)(tok + 2 + u) * DM + 4 * lane + 256 * j)); ny[u][j] = *(const u32x2*)(X1 + (size_t)(tok + 2 + u) * DM + 4 * lane + 256 * j); }
            }
#pragma unroll
            for (int u = 0; u < 2; ++u) {
                bf16_t* x1r = X1 + (size_t)(tok + u) * DM;
#pragma unroll
                for (int j = 0; j < 4; ++j) { const u32x2 y = yv[u][j];
                    v[u][j][0] += bf2f(y.x & 0xffffu); v[u][j][1] += bf2f(y.x >> 16); v[u][j][2] += bf2f(y.y & 0xffffu); v[u][j][3] += bf2f(y.y >> 16);
                    u32x2 w; w.x = cvt_pk_bf16(v[u][j][0], v[u][j][1]); w.y = cvt_pk_bf16(v[u][j][2], v[u][j][3]); *(u32x2*)(x1r + 4 * lane + 256 * j) = w;
                    s[u] += (v[u][j][0] * v[u][j][0] + v[u][j][1] * v[u][j][1]) + (v[u][j][2] * v[u][j][2] + v[u][j][3] * v[u][j][3]); }
            }
#pragma unroll
            for (int o = 1; o < 64; o <<= 1) { const float t0 = __shfl_xor(s[0], o), t1 = __shfl_xor(s[1], o); s[0] += t0; s[1] += t1; }
            float rstd[2];
#pragma unroll
            for (int u = 0; u < 2; ++u) rstd[u] = rsqrtf(s[u] * (1.0f / DM) + EPS);
            float gl8[2][8];
#pragma unroll
            for (int u = 0; u < 2; ++u)
#pragma unroll
                for (int e = 0; e < 8; ++e) gl8[u][e] = 0.f;
#pragma unroll
            for (int j = 0; j < 4; ++j) {
                const int col = 4 * lane + 256 * j;
                const f32x4 g = *(const f32x4*)(p.g_ffn + col), sh = *(const f32x4*)(mod + b * 6144 + 3072 + col), scl = *(const f32x4*)(mod + b * 6144 + 4096 + col);
#pragma unroll
                for (int u = 0; u < 2; ++u) {
#pragma unroll
                    for (int q = 0; q < 4; ++q) { v[u][j][q] = v[u][j][q] * rstd[u] * g[q] * (1.0f + scl[q]) + sh[q];
                        gl8[u][0] += v[u][j][q] * wg[j][q][0]; gl8[u][1] += v[u][j][q] * wg[j][q][1]; gl8[u][2] += v[u][j][q] * wg[j][q][2]; gl8[u][3] += v[u][j][q] * wg[j][q][3]; }
                    *(unsigned*)((unsigned char*)H2 + (size_t)(tok + u) * DM + col) = pk4_fp8(v[u][j][0], v[u][j][1], v[u][j][2], v[u][j][3]);
                }
            }
            float gr[2];
            gr[0] = tr_reduce8(gl8[0], lane); gr[1] = tr_reduce8(gl8[1], lane);
            int gs[2]; float pgrp[2];
#pragma unroll
            for (int u = 0; u < 2; ++u) {
                float gl[4];
#pragma unroll
                for (int q = 0; q < 4; ++q) gl[q] = __int_as_float(__builtin_amdgcn_readlane(__float_as_int(gr[u]), 8 * q)) + p.b_group[q];
                int gsel = 0; float gm = gl[0];
#pragma unroll
                for (int q = 1; q < 4; ++q) if (gl[q] > gm) { gm = gl[q]; gsel = q; }
                float den = 0.f;
#pragma unroll
                for (int q = 0; q < 4; ++q) den += expf(gl[q] - gm);
                pgrp[u] = 1.0f / den; gs[u] = gsel;
            }
            float rl8[2][8];
#pragma unroll
            for (int u = 0; u < 2; ++u) {
#pragma unroll
                for (int e = 0; e < 8; ++e) rl8[u][e] = 0.f;
#pragma unroll
                for (int j = 0; j < 4; ++j)
#pragma unroll
                    for (int q = 0; q < 4; ++q) {
                        const f32x4 w0 = WR[(((gs[u] * 4 + j) * 4 + q) * 2 + 0) * 64 + lane], w1 = WR[(((gs[u] * 4 + j) * 4 + q) * 2 + 1) * 64 + lane];
#pragma unroll
                        for (int e = 0; e < 4; ++e) { rl8[u][e] += v[u][j][q] * w0[e]; rl8[u][4 + e] += v[u][j][q] * w1[e]; }
                    }
            }
            float rr[2];
            rr[0] = tr_reduce8(rl8[0], lane); rr[1] = tr_reduce8(rl8[1], lane);
#pragma unroll
            for (int u = 0; u < 2; ++u) {
                float rl[8];
#pragma unroll
                for (int e = 0; e < 8; ++e) rl[e] = __int_as_float(__builtin_amdgcn_readlane(__float_as_int(rr[u]), 8 * e)) + p.b_router[gs[u] * 8 + e];
                int i1 = 0; float m1 = rl[0];
#pragma unroll
                for (int e = 1; e < 8; ++e) if (rl[e] > m1) { m1 = rl[e]; i1 = e; }
                int i2 = (i1 == 0) ? 1 : 0; float m2 = -3.0e38f;
#pragma unroll
                for (int e = 0; e < 8; ++e) if (e != i1 && rl[e] > m2) { m2 = rl[e]; i2 = e; }
                const float p1 = 1.0f / (1.0f + expf(m2 - m1)), p2 = 1.0f - p1;
                if (lane < 2) {
                    const int eid = gs[u] * 8 + (lane == 0 ? i1 : i2);
                    const int rk = __hip_atomic_fetch_add(hist + eid, 1, __ATOMIC_RELAXED, __HIP_MEMORY_SCOPE_WORKGROUP);
                    asg[(it + u) * 2 + lane] = eid | (rk << 8); asg[32 + (it + u) * 2 + lane] = __float_as_int(pgrp[u] * (lane == 0 ? p1 : p2));
                }
            }
        }
        __syncthreads();
        if (tid < 32) basee[tid] = atomicAdd(cnt + tid * CNT_STRIDE, hist[tid]);
        __syncthreads();
        if (lane < 32) {
            const int a = asg[lane], e = a & 255, rk = a >> 8; const int tok = blk * TPB + wave * 16 + (lane >> 1); const int pos = basee[e] + rk;
            if (pos >= 0 && pos < NTOK) inv[(size_t)e * NTOK + pos] = (int)((unsigned)(tok * 2 + (lane & 1)) | (cvt_pk_bf16(__int_as_float(asg[32 + lane]), 0.f) << 16));
        }
        __syncthreads();
    }
}
__device__ __forceinline__ void moe_table(const Params& p, LAS unsigned char* lds) {
    LAS int* tab = (LAS int*)(lds + LDS_TAB);
    const int* cnt = (const int*)(p.ws + WS_CTL);
    const int tid = threadIdx.x;
    __syncthreads();
    if (tid < 64) {
        int c = 0; if (tid < 32) { c = __hip_atomic_load(cnt + tid * CNT_STRIDE, __ATOMIC_RELAXED, __HIP_MEMORY_SCOPE_AGENT); tab[64 + tid] = c; }
        const int n = (c + 255) >> 8; int s = n;
#pragma unroll
        for (int o = 1; o < 64; o <<= 1) { const int t = __shfl_up(s, o); if (tid >= o) s += t; }
        if (tid <= 32) tab[tid] = s - n;
    }
    __syncthreads();
    for (int mt = tid; mt < MAXMT; mt += 512) { int e = 0;
#pragma unroll
        for (int k = 1; k < 32; ++k) e += (tab[k] <= mt) ? 1 : 0;
        ((LAS unsigned char*)tab)[384 + mt] = (unsigned char)e; }
    __syncthreads();
}
__device__ __forceinline__ void phase_final(const Params& p) {
    const int tid = threadIdx.x, lane = tid & 63, wave = tid >> 6, G = gridDim.x;
    const int gw = blockIdx.x * 8 + wave, NW = G * 8;
    const float* mod = (const float*)(p.ws + WS_MOD); const bf16_t* Y = (const bf16_t*)(p.ws + WS_Y); const bf16_t* X1 = (const bf16_t*)(p.ws + WS_X1);
    constexpr int NT = 2;
    for (int t0 = gw * NT; t0 < NTOK; t0 += NW * NT) {
        const int b = t0 / SEQ;
        u32x4 xx[NT][2], ya[NT][2], yb[NT][2];
#pragma unroll
        for (int u = 0; u < NT; ++u)
#pragma unroll
            for (int j = 0; j < 2; ++j) { const int col = 8 * lane + 512 * j; const size_t tok = t0 + u;
                xx[u][j] = NT_LD((const u32x4*)(X1 + tok * DM + col)); ya[u][j] = NT_LD((const u32x4*)(Y + (2 * tok) * DM + col)); yb[u][j] = NT_LD((const u32x4*)(Y + (2 * tok + 1) * DM + col)); }
        f32x4 ga[2][2], gf[2][2];
#pragma unroll
        for (int j = 0; j < 2; ++j) { const int col = 8 * lane + 512 * j;
            ga[j][0] = *(const f32x4*)(mod + b * 6144 + 5120 + col); ga[j][1] = *(const f32x4*)(mod + b * 6144 + 5120 + col + 4);
            gf[j][0] = *(const f32x4*)(p.g_final + col); gf[j][1] = *(const f32x4*)(p.g_final + col + 4); }
#pragma unroll
        for (int u = 0; u < NT; ++u) {
            f32x4 v[2][2]; float s = 0.f;
#pragma unroll
            for (int j = 0; j < 2; ++j) {
                const u32x4 X = xx[u][j], A = ya[u][j], B = yb[u][j];
                v[j][0][0] = bf2f(X.x & 0xffffu) + ga[j][0][0] * (bf2f(A.x & 0xffffu) + bf2f(B.x & 0xffffu)); v[j][0][1] = bf2f(X.x >> 16) + ga[j][0][1] * (bf2f(A.x >> 16) + bf2f(B.x >> 16));
                v[j][0][2] = bf2f(X.y & 0xffffu) + ga[j][0][2] * (bf2f(A.y & 0xffffu) + bf2f(B.y & 0xffffu)); v[j][0][3] = bf2f(X.y >> 16) + ga[j][0][3] * (bf2f(A.y >> 16) + bf2f(B.y >> 16));
                v[j][1][0] = bf2f(X.z & 0xffffu) + ga[j][1][0] * (bf2f(A.z & 0xffffu) + bf2f(B.z & 0xffffu)); v[j][1][1] = bf2f(X.z >> 16) + ga[j][1][1] * (bf2f(A.z >> 16) + bf2f(B.z >> 16));
                v[j][1][2] = bf2f(X.w & 0xffffu) + ga[j][1][2] * (bf2f(A.w & 0xffffu) + bf2f(B.w & 0xffffu)); v[j][1][3] = bf2f(X.w >> 16) + ga[j][1][3] * (bf2f(A.w >> 16) + bf2f(B.w >> 16));
#pragma unroll
                for (int h = 0; h < 2; ++h) s += (v[j][h][0] * v[j][h][0] + v[j][h][1] * v[j][h][1]) + (v[j][h][2] * v[j][h][2] + v[j][h][3] * v[j][h][3]);
            }
            const float rstd = rsqrtf(wave_sum(s) * (1.0f / DM) + EPS);
            float* orow = p.out + (size_t)(t0 + u) * DM;
#pragma unroll
            for (int j = 0; j < 2; ++j)
#pragma unroll
                for (int h = 0; h < 2; ++h) NT_ST(v[j][h] * rstd * gf[j][h], (f32x4*)(orow + 8 * lane + 512 * j + 4 * h));
        }
    }
}

#define XB_TMO      128
#define XB_XCNT(j)  (256  + 64 * (j))
#define XB_XSUB(j)  (1280 + 64 * (j))
#define XB_XGEN(j)  (2304 + 64 * (j))
#define XB_TOP      3328
#define XB_TOPGEN   3392
#define XCD_BAR_WORDS 3456
#define XB_SPIN_CAP (1u << 18)
__device__ __forceinline__ unsigned xb_ld(unsigned* p)              { return __hip_atomic_load(p, __ATOMIC_RELAXED, __HIP_MEMORY_SCOPE_AGENT); }
__device__ __forceinline__ unsigned xb_add(unsigned* p, unsigned v) { return __hip_atomic_fetch_add(p, v, __ATOMIC_RELAXED, __HIP_MEMORY_SCOPE_AGENT); }
__device__ __forceinline__ unsigned xb_xcc_id() { return (unsigned)__builtin_amdgcn_s_getreg((3 << 11) | 20) & 0xFu; }
#define XB_SPIN(cond, bar) do { unsigned _sp = 0; while (cond) { __builtin_amdgcn_s_sleep(1); \
    if ((++_sp & 255u) == 0u) { if (xb_ld(&(bar)[XB_TMO])) break; if (_sp > XB_SPIN_CAP) { atomicAdd(&(bar)[XB_TMO], 1u); break; } } } } while (0)
struct XcdBarrier { unsigned* bar; unsigned x; volatile LAS unsigned* st; };
__device__ __forceinline__ XcdBarrier xcd_barrier_post(unsigned* bar, volatile LAS unsigned* st) {
    XcdBarrier b; b.bar = bar; b.x = xb_xcc_id(); b.st = st;
    if (threadIdx.x == 0) (void)xb_add(&bar[XB_XCNT(b.x)], 1u);
    return b;
}
__device__ __forceinline__ void xcd_barrier_complete(unsigned* bar, unsigned x, unsigned& nloc, unsigned& nx) {
    const unsigned G = gridDim.x * gridDim.y * gridDim.z;
    unsigned sum, cnt, mine, sp = 0u;
    for (;;) {
        sum = 0u; cnt = 0u; mine = 0u;
#pragma unroll
        for (unsigned j = 0; j < 16; ++j) { const unsigned c = xb_ld(&bar[XB_XCNT(j)]); sum += c; cnt += (c > 0u) ? 1u : 0u; mine = (j == x) ? c : mine; }
        if (sum == G) break;
        __builtin_amdgcn_s_sleep(1);
        if ((++sp & 255u) == 0u) { if (xb_ld(&bar[XB_TMO])) break; if (sp > XB_SPIN_CAP) { atomicAdd(&bar[XB_TMO], 1u); break; } }
    }
    nloc = mine > 0u ? mine : 1u; nx = cnt > 0u ? cnt : 1u;
}
__device__ __forceinline__ void xcd_barrier(const XcdBarrier& b) {
    asm volatile("s_waitcnt vmcnt(0)" ::: "memory");
    __syncthreads();
    if (threadIdx.x == 0) {
        unsigned* bar = b.bar;
        __builtin_amdgcn_s_waitcnt(0);
        unsigned nloc = b.st[0], nx = b.st[1];
        if (nloc == 0u) { xcd_barrier_complete(bar, b.x, nloc, nx); b.st[0] = nloc; b.st[1] = nx; }
        const unsigned old = xb_add(&bar[XB_XSUB(b.x)], 1u);
        const unsigned gen = old / nloc;
        if (old + 1u == (gen + 1u) * nloc) {
            __builtin_amdgcn_fence(__ATOMIC_RELEASE, "agent");
            asm volatile("s_waitcnt vmcnt(0)" ::: "memory");
            const unsigned og = xb_add(&bar[XB_TOP], 1u);
            const unsigned tg = og / nx;
            if (og + 1u == (tg + 1u) * nx) xb_add(&bar[XB_TOPGEN], 1u);
            else XB_SPIN(xb_ld(&bar[XB_TOPGEN]) == tg, bar);
            __builtin_amdgcn_fence(__ATOMIC_ACQUIRE, "agent");
            xb_add(&bar[XB_XGEN(b.x)], 1u);
            asm volatile("s_waitcnt vmcnt(0)" ::: "memory");
        } else {
            XB_SPIN(xb_ld(&bar[XB_XGEN(b.x)]) == gen, bar);
            __builtin_amdgcn_fence(__ATOMIC_ACQUIRE, "agent");
            asm volatile("s_waitcnt vmcnt(0)" ::: "memory");
        }
    }
    __syncthreads();
}

#define RUN_PHASE(n, ...) if ((p.phases >> (n)) & 1u) { if ((n) > 0) xcd_barrier(xb); __VA_ARGS__; }
__global__ void __launch_bounds__(512, 2) fwd_kernel(Params p) {
    extern __shared__ __attribute__((aligned(16))) unsigned char shm[];
    LAS unsigned char* lds = (LAS unsigned char*)shm;
    cg::grid_group grid = cg::this_grid();
    const int G = gridDim.x, c = blockIdx.x;
    volatile LAS unsigned* xst = (volatile LAS unsigned*)(lds + LDS_TAB + 1008);
    if (threadIdx.x == 0) { xst[0] = 0u; xst[1] = 0u; }
    __syncthreads();
    XcdBarrier xb; xb.bar = (unsigned*)(p.ws + WS_BAR); xb.x = 0u; xb.st = xst;
    xb = xcd_barrier_post((unsigned*)(p.ws + WS_BAR), xst);
    if (p.ws == nullptr) grid.sync();
    RUN_PHASE(0, phase0(p, lds);)
    RUN_PHASE(1, phase1(p, lds);)
    RUN_PHASE(2, { SchedDenseT<true> S; S.A = (const char*)(p.ws + WS_HX); S.Bt = (const char*)(p.ws + WS_WINT8); S.K = DM / 2; S.nM = NTOK / 256; S.nN = DIN / 256; S.G = G; S.c = c; S.nextra = (G > 48) ? 0 : 24; S.ex_pm0 = NTOK / 256; S.ex_pn0 = 4; S.ex_nn = 6;
                  EpiPT<true> E; E.P = (bf16_t*)(p.ws + WS_P); E.lbl = p.lb_logits; E.sa = (const float*)(p.ws + WS_SA); E.cmax = (const float*)(p.ws + WS_CMAX);
                  { LAS float* lcm = (LAS float*)(lds + LDS_GEMM); LAS float* llb = lcm + DIN;
                    for (int i = threadIdx.x; i < DIN; i += 512) lcm[i] = E.cmax[i];
                    for (int i = threadIdx.x; i < 1024; i += 512) { const int dir = i >> 9, cc = i & 511; llb[i] = sigmoid_f(p.lb_logits[dir * 1024 + cc] - p.lb_logits[dir * 1024 + 512 + cc]); }
                    E.lcm = lcm; E.llb = llb; E.lrs = llb + 1024; __syncthreads(); }
                  pg8::gemm_phase(lds, DM / 2, S, E); })
    RUN_PHASE(3, { hgrn_pass1(p, lds); __syncthreads(); phase_mix(p, lds); })
    RUN_PHASE(4, hgrn_combine(p);)
    RUN_PHASE(5, hgrn_pass3(p, lds);)
    RUN_PHASE(7, { SchedDenseT<false> S; S.A = (const char*)(p.ws + WS_A2); S.Bt = (const char*)(p.ws + WS_WOUTT); S.K = DM; S.nM = NTOK / 256; S.nN = DM / 256; S.G = G; S.c = c; S.nextra = 0; S.ex_pm0 = 0; S.ex_pn0 = 0; S.ex_nn = 1;
                  EpiX1 E; E.out = (bf16_t*)(p.ws + WS_X1);
                  { LAS float* lga = (LAS float*)(lds + LDS_GEMM); const float* mod = (const float*)(p.ws + WS_MOD);
                    for (int i = threadIdx.x; i < 4096; i += 512) lga[i] = mod[(i >> 10) * 6144 + 2048 + (i & 1023)];
                    E.lga = lga; __syncthreads(); }
                  pg8::gemm_phase(lds, DM, S, E); })
    RUN_PHASE(8, phase_route(p, lds);)
#define MOE_SCHED_A(S_) SchedMoE<true> S_; S_.A = (const char*)(p.ws + WS_H2); S_.W = (const char*)(p.ws + WS_W13T); S_.wstride = (size_t)1024 * 1024; S_.K = DM / 2; S_.G = G; S_.c = c; S_.tab = (LAS const int*)(lds + LDS_TAB); S_.inv = (const int*)(p.ws + WS_INV); S_.l_first = 0; S_.l_count = 0; S_.l_stride = 1; S_.dep = nullptr; S_.dep_lo = 0
#define MOE_SCHED_B(S_) SchedMoE<false> S_; S_.A = (const char*)(p.ws + WS_HH); S_.W = (const char*)(p.ws + WS_W2T); S_.wstride = (size_t)1024 * 512; S_.K = DE / 2; S_.G = G; S_.c = c; S_.tab = (LAS const int*)(lds + LDS_TAB); S_.inv = (const int*)(p.ws + WS_INV); S_.i_lo = 0; S_.i_hi = -1; S_.dep = (unsigned*)(p.ws + WS_CTL); S_.dep_lo = 0x7fffffff
#define MOE_EPI_Y(E_) EpiY E_; E_.Y = (bf16_t*)(p.ws + WS_Y); E_.inv = (const int*)(p.ws + WS_INV); E_.tab = (LAS const int*)(lds + LDS_TAB); E_.lpe = (LAS unsigned*)(lds + LDS_GEMM)
#define MOE_GEOM const int total = ((LAS const int*)(lds + LDS_TAB))[32]; const int MPR = G >> 2; const int FR = total / MPR, R = total - FR * MPR; const int mc = (c & 7) * (G >> 5) + (c >> 5), pnc = (c >> 3) & 3; \
                 const bool tail = mc < R; const int n2 = 4 * R, n1 = G - n2, NB_ = 4 * total; const int qo = (NB_ + 2 * n2 + G - 1) / G, qt = qo >= 2 ? qo - 2 : 0
    RUN_PHASE(9, { moe_table(p, lds); MOE_GEOM; (void)tail; (void)pnc; (void)n1; (void)qt; MOE_SCHED_A(S); S.i_lo = 0; S.i_hi = FR;
                  EpiH E; E.H = (bf16_t*)(p.ws + WS_HH); pg8::gemm_phase(lds, DM / 2, S, E); })
    RUN_PHASE(10, { moe_table(p, lds); MOE_GEOM;
                  if (tail) { MOE_SCHED_A(S); S.i_lo = FR; S.i_hi = FR + 1; EpiH E; E.H = (bf16_t*)(p.ws + WS_HH); pg8::gemm_phase(lds, DM / 2, S, E); __syncthreads();
                              if (threadIdx.x == 0) { __builtin_amdgcn_fence(__ATOMIC_RELEASE, "agent"); asm volatile("s_waitcnt vmcnt(0)" ::: "memory");
                                                      __hip_atomic_fetch_add((unsigned*)(p.ws + WS_CTL) + 8 * mc + 1, 1u, __ATOMIC_RELAXED, __HIP_MEMORY_SCOPE_AGENT); } }
                  { MOE_SCHED_B(S); int cap; if (tail) { S.l_first = n1 * qo + (mc * 4 + pnc) * qt; cap = qt; } else { S.l_first = ((mc - R) * 4 + pnc) * qo; cap = qo; }
                    const int left = NB_ - S.l_first; S.l_count = left < cap ? (left > 0 ? left : 0) : cap; S.l_stride = 1; S.dep_lo = FR * MPR;
                    MOE_EPI_Y(E); pg8::gemm_phase(lds, DE / 2, S, E); } })
    RUN_PHASE(12, phase_final(p);)
}

extern "C" void kernel_launch(void* const* d_in, const int* in_sizes, int n_in, void* d_out, int out_size, void* d_ws, size_t ws_size, hipStream_t stream) {
    static int grid_blocks = 0;
    if (grid_blocks == 0) {
        if (n_in != 22 || in_sizes[0] != NTOK * DM || out_size != NTOK * DM || ws_size < WS_END) {
            fprintf(stderr, "kernel_launch: unexpected shapes: n_in %d in0 %d out %d ws %zu (need %zu)\n", n_in, n_in > 0 ? in_sizes[0] : -1, out_size, ws_size, (size_t)WS_END); grid_blocks = -1; return; }
        int dev = 0, cus = 0, per_cu = 0;
        if (hipGetDevice(&dev) != hipSuccess || hipDeviceGetAttribute(&cus, hipDeviceAttributeMultiprocessorCount, dev) != hipSuccess) { grid_blocks = -1; return; }
        if (hipFuncSetAttribute((const void*)fwd_kernel, hipFuncAttributeMaxDynamicSharedMemorySize, LDS_BYTES) != hipSuccess) { fprintf(stderr, "kernel_launch: hipFuncSetAttribute failed\n"); grid_blocks = -1; return; }
        if (hipOccupancyMaxActiveBlocksPerMultiprocessor(&per_cu, (const void*)fwd_kernel, 512, LDS_BYTES) != hipSuccess || per_cu < 1) { fprintf(stderr, "kernel_launch: occupancy query says %d blocks/CU\n", per_cu); (void)hipGetLastError(); per_cu = 1; }
        grid_blocks = cus;
        if (grid_blocks % 32 != 0) { fprintf(stderr, "kernel_launch: CU count %d not a multiple of 32\n", cus); grid_blocks = (cus / 32) * 32; }
    }
    if (grid_blocks <= 0) return;
    Params p{};
    const float** f = (const float**)&p;
    for (int i = 0; i < 22; ++i) f[i] = (const float*)d_in[i];
    p.out = (float*)d_out; p.ws = (unsigned char*)d_ws; p.phases = 0x17FFu; p.pad = 0u;
    if (hipMemsetAsync((char*)d_ws + WS_BAR, 0, 32768, stream) != hipSuccess) { fprintf(stderr, "kernel_launch: memset of the barrier words failed\n"); return; }
    void* args[] = {&p};
    hipError_t e = hipLaunchCooperativeKernel((const void*)fwd_kernel, dim3(grid_blocks), dim3(512), args, LDS_BYTES, stream);
    if (e != hipSuccess) fprintf(stderr, "cooperative launch failed: %s (grid %d)\n", hipGetErrorString(e), grid_blocks);
}
```

```cpp
#include <hip/hip_runtime.h>
#include <hip/hip_cooperative_groups.h>
#include <cstdio>
#include <cstdint>
namespace cg = cooperative_groups;


#define LAS __attribute__((address_space(3)))
typedef unsigned short bf16_t;
typedef short bf16x8 __attribute__((ext_vector_type(8)));
typedef float f32x4 __attribute__((ext_vector_type(4)));
typedef float f32x2 __attribute__((ext_vector_type(2)));
typedef unsigned u32x4 __attribute__((ext_vector_type(4)));
typedef unsigned u32x2 __attribute__((ext_vector_type(2)));

constexpr int DM = 1024, NB = 4, SEQ = 8192, NTOK = NB * SEQ, CTXL = 256, NCTX = NB * CTXL, MROWS = NTOK + NCTX;
constexpr int DIN = 3072, HD = 128, NH = 4, NE = 32, DE = 512;
constexpr int SCL = 256, NSC = SEQ / SCL;
constexpr float EPS = 1e-6f;

constexpr size_t WS_CTL = 0;
constexpr size_t WS_MOD = 4096;
constexpr size_t WS_WINT = 131072;
constexpr size_t WS_WOUTT = WS_WINT + (size_t)DIN * DM * 2;
constexpr size_t WS_WPT = WS_WOUTT + (size_t)DM * DM * 2;
constexpr size_t WS_W13T = WS_WPT + (size_t)4 * 128 * 128 * 2;
constexpr size_t WS_W2T = WS_W13T + (size_t)NE * 1024 * 1024 * 2;
constexpr size_t WS_HX = WS_W2T + (size_t)NE * 1024 * 512 * 2;
constexpr size_t WS_P = WS_HX + (size_t)MROWS * DM * 2;
constexpr size_t WS_SL = WS_P + (size_t)MROWS * DIN * 2;
constexpr size_t WS_DL = WS_SL + (size_t)32 * (NSC + 1) * 128 * 128 * 4;
constexpr size_t WS_O = WS_DL + (size_t)32 * (NSC + 1) * 128 * 4;
constexpr size_t WS_BAR = WS_O + (size_t)2 * NTOK * 512 * 2;
constexpr size_t WS_CMAX = WS_BAR + 16384;
constexpr size_t WS_WINT8 = WS_CMAX + 16384;
constexpr size_t WS_SA = WS_WINT8 + (size_t)DIN * DM;
constexpr size_t WS_END = WS_SA + (size_t)MROWS * 4;
constexpr size_t WS_HXC = WS_HX + (size_t)MROWS * DM;
static_assert(WS_END <= (size_t)536870912, "workspace");
constexpr size_t WS_A2 = WS_HX;
constexpr size_t WS_H2 = WS_HX;
constexpr size_t WS_X1 = WS_P;
constexpr int MAXMT = NTOK * 2 / 256 + NE;
constexpr size_t WS_HH = WS_X1 + (size_t)NTOK * DM * 2;
constexpr size_t WS_GATE = WS_HH + (size_t)MAXMT * 256 * DE * 2;
constexpr size_t WS_INV = WS_GATE + (size_t)NTOK * 2 * 4;
constexpr size_t WS_P_USED_END = WS_INV + (size_t)NE * NTOK * 4;
constexpr size_t WS_Y = WS_SL;
constexpr float Y8_SCALE = 16.0f, Y8_INV = 1.0f / 16.0f;
static_assert(WS_P_USED_END <= WS_SL, "alias overflow P");
static_assert(WS_Y + (size_t)NTOK * 2 * DM <= WS_BAR, "alias overflow Y");

constexpr int LDS_GEMM = 131072;
constexpr int LDS_TAB = 159744;
constexpr int LDS_BYTES = 163840;

struct Params {
    const float *x, *c, *ctx, *c_ctx, *w_ada, *b_ada, *g_mix, *g_ffn, *w_in, *w_pool, *s_pool, *lb_logits, *g_hnorm, *w_out;
    const float *w_group, *b_group, *w_router, *b_router, *w1, *w3, *w2, *g_final;
    float* out; unsigned char* ws;
    unsigned phases, pad;
};

__device__ __forceinline__ size_t p_off(int cb, int row) { return ((size_t)cb * MROWS + (size_t)row) * 128; }
typedef int v8i32 __attribute__((ext_vector_type(8)));
typedef int v4i32 __attribute__((ext_vector_type(4)));
__device__ __forceinline__ float clamp_fp8(float x) { return __builtin_amdgcn_fmed3f(x, -448.0f, 448.0f); }
__device__ __forceinline__ unsigned pk4_fp8(float a, float b, float c, float d) {
    int w = 0; w = __builtin_amdgcn_cvt_pk_fp8_f32(clamp_fp8(a), clamp_fp8(b), w, false); w = __builtin_amdgcn_cvt_pk_fp8_f32(clamp_fp8(c), clamp_fp8(d), w, true); return (unsigned)w; }
constexpr float W8_SCALE = 32.0f, W8_INV = 1.0f / 32.0f;
#define NT_LD(ptr) __builtin_nontemporal_load(ptr)
#define NT_ST(val, ptr) __builtin_nontemporal_store(val, ptr)
__device__ __forceinline__ float bf2f(unsigned b) { return __uint_as_float(b << 16); }
typedef __bf16 bf16v2 __attribute__((ext_vector_type(2)));
__device__ __forceinline__ unsigned cvt_pk_bf16(float lo, float hi) { f32x2 v = {lo, hi}; bf16v2 b = __builtin_convertvector(v, bf16v2); return __builtin_bit_cast(unsigned, b); }
__device__ __forceinline__ float wave_max(float v) {
#pragma unroll
    for (int o = 1; o < 64; o <<= 1) v = fmaxf(v, __shfl_xor(v, o));
    return v;
}
__device__ __forceinline__ unsigned pk4_i8(float a, float b, float c, float d) {
    const int i0 = (int)rintf(a), i1 = (int)rintf(b), i2 = (int)rintf(c), i3 = (int)rintf(d);
    return (unsigned)(i0 & 255) | ((unsigned)(i1 & 255) << 8) | ((unsigned)(i2 & 255) << 16) | ((unsigned)i3 << 24);
}
__device__ __forceinline__ float wave_sum(float v) {
#pragma unroll
    for (int o = 1; o < 64; o <<= 1) v += __shfl_xor(v, o);
    return v;
}
__device__ __forceinline__ float fast_exp(float x) { return __builtin_amdgcn_exp2f(x * 1.44269504089f); }
__device__ __forceinline__ float fast_log(float x) { return __builtin_amdgcn_logf(x) * 0.69314718056f; }
__device__ __forceinline__ float ex2(float x) { return __builtin_amdgcn_exp2f(x); }
__device__ __forceinline__ float sigmoid_f(float z) { return __builtin_amdgcn_rcpf(1.0f + fast_exp(-z)); }
__device__ __forceinline__ float silu_f(float z) { return z * sigmoid_f(z); }

namespace pg8 {
constexpr int BM = 256, BK = 64, HALF = 128, HTB = HALF * BK * 2, NXCD = 8, WGM = 8;
__device__ __forceinline__ int lds_byte(int r, int c) { const int st = (r >> 4) * 2 + (c >> 5), rr = r & 15, cc = c & 31, ob = rr * 64 + cc * 2; return st * 1024 + (ob ^ (((ob >> 9) & 1) << 5)); }
__device__ __forceinline__ void stage_rc(int b, int& R, int& C) { const int st = b / 1024, sb = b % 1024, swz = sb ^ (((sb >> 9) & 1) << 5); R = (st >> 1) * 16 + swz / 64; C = (st & 1) * 32 + (swz % 64) / 2; }
__device__ __forceinline__ int perm32(int rho) { const int n = rho >> 4, i = rho & 15; return 8 * (i >> 2) + 4 * n + (i & 3); }

struct Unit { int pm, pn, e, aux; };

__device__ __forceinline__ void static_map(int L, int nM, int nN, int& pm, int& pn) {
    const int nwg = nM * nN; int wgid = L;
    { const int q = nwg / NXCD, r = nwg % NXCD, xcd = wgid % NXCD, off = wgid / NXCD; wgid = (xcd < r ? xcd * (q + 1) : r * (q + 1) + (xcd - r) * q) + off; }
    const int nig = WGM * nN, gid = wgid / nig, fm = gid * WGM, gsz = (nM - fm) < WGM ? (nM - fm) : WGM;
    pm = fm + ((wgid % nig) % gsz); pn = (wgid % nig) / gsz;
}

template <class Epi, class Sched>
__device__ __forceinline__ void gemm_phase(LAS unsigned char* lds, const int K, const Sched& S, const Epi& E) {
    const int tid = threadIdx.x, wid = __builtin_amdgcn_readfirstlane(tid >> 6), lane = tid & 63, wr = wid >> 2, wc = wid & 3, fr = lane & 15, fq = lane >> 4;
    const int nt = K / BK;
    int sR[2], sC[2]; unsigned voffB[2];
#pragma unroll
    for (int i = 0; i < 2; ++i) { int R, C; stage_rc(tid * 16 + i * 8192, R, C); sR[i] = R; sC[i] = C; const int Rb = Epi::PERM ? ((R & ~31) + perm32(R & 31)) : R; voffB[i] = (unsigned)(Rb * K + C) * 2u; }
    const size_t kstep = (size_t)(BK * 2);
    const size_t hstep = (size_t)HALF * K * 2;
    const unsigned ldsw = (unsigned)wid * 1024u;
    const int aoff = lds_byte(wr * 64 + fr, fq * 8), boff = lds_byte(wc * 32 + fr, fq * 8);
#define PG8_SA(b, h) (((b) * 2 + (h)) * HTB)
#define PG8_SB(b, h) ((4 + (b) * 2 + (h)) * HTB)
#define PG8_STAGE(bufoff, gbase, voff) do { _Pragma("unroll") for (int _i = 0; _i < 2; ++_i) \
        __builtin_amdgcn_global_load_lds((const unsigned*)((const char*)(gbase) + (voff)[_i]), (LAS unsigned*)(lds + (bufoff) + ldsw + _i * 8192), 16, 0, 0); } while (0)
#define PG8_LD2(base_) __builtin_shufflevector(*(const LAS v4i32*)(base_), *(const LAS v4i32*)((base_) + 1024), 0, 1, 2, 3, 4, 5, 6, 7)
#define PG8_LDA(dst, b, h) do { if constexpr (Sched::FP8) { _Pragma("unroll") for (int m = 0; m < 4; ++m) dst##8[m] = PG8_LD2(lds + PG8_SA(b, h) + aoff + m * 2048); } \
        else { _Pragma("unroll") for (int m = 0; m < 4; ++m) _Pragma("unroll") for (int k = 0; k < 2; ++k) dst[m][k] = *(const LAS bf16x8*)(lds + PG8_SA(b, h) + aoff + m * 2048 + k * 1024); } } while (0)
#define PG8_LDB(dst, b, h) do { if constexpr (Sched::FP8) { _Pragma("unroll") for (int n = 0; n < 2; ++n) dst##8[n] = PG8_LD2(lds + PG8_SB(b, h) + boff + n * 2048); } \
        else { _Pragma("unroll") for (int n = 0; n < 2; ++n) _Pragma("unroll") for (int k = 0; k < 2; ++k) dst[n][k] = *(const LAS bf16x8*)(lds + PG8_SB(b, h) + boff + n * 2048 + k * 1024); } } while (0)
#define PG8_MMA(ai, bj, At, Bt) do { __builtin_amdgcn_s_setprio(1); _Pragma("unroll") for (int m = 0; m < 4; ++m) _Pragma("unroll") for (int n = 0; n < 2; ++n) { \
        if constexpr (Sched::FP8) asm volatile("v_mfma_scale_f32_16x16x128_f8f6f4 %0, %1, %2, %0, %3, %3 op_sel_hi:[0,0,0]" : "+v"(acc[ai][bj][m][n]) : "v"(Bt##8[n]), "v"(At##8[m]), "v"(mxscale)); \
        else if constexpr (Sched::I8) { _Pragma("unroll") for (int k = 0; k < 2; ++k) acc[ai][bj][m][n] = __builtin_bit_cast(f32x4, __builtin_amdgcn_mfma_i32_16x16x64_i8( \
                __builtin_bit_cast(v4i32, Bt[n][k]), __builtin_bit_cast(v4i32, At[m][k]), __builtin_bit_cast(v4i32, acc[ai][bj][m][n]), 0, 0, 0)); } \
        else { _Pragma("unroll") for (int k = 0; k < 2; ++k) acc[ai][bj][m][n] = __builtin_amdgcn_mfma_f32_16x16x32_bf16(Bt[n][k], At[m][k], acc[ai][bj][m][n], 0, 0, 0); } } \
        __builtin_amdgcn_s_setprio(0); } while (0)
#define PG8_WAIT_V(n) asm volatile("s_waitcnt vmcnt(" #n ")" ::: "memory")
#define PG8_WAIT_L(n) asm volatile("s_waitcnt lgkmcnt(" #n ")" ::: "memory")
#define PG8_BAR __builtin_amdgcn_s_barrier()
#define PG8_SCHED __builtin_amdgcn_sched_barrier(0)
    Unit cur, nxt; int ui = 0;
    if (!S.next(0, cur)) return;
    f32x4 acc[2][2][4][2];
#pragma unroll
    for (int a = 0; a < 2; ++a)
#pragma unroll
        for (int b = 0; b < 2; ++b)
#pragma unroll
            for (int m = 0; m < 4; ++m)
#pragma unroll
                for (int n = 0; n < 2; ++n) acc[a][b][m][n] = (f32x4){0.f, 0.f, 0.f, 0.f};
    bf16x8 At[4][2], B0[2][2], B1[2][2]; v8i32 At8[4], B08[2], B18[2];
    const int mxscale = 0x7F7F7F7F;
    unsigned voA[2][2], voN[2][2];
    S.a_off(cur, sR, sC, voA);
    const char* cA = S.a_base(cur); const char* cB = S.b_base(cur);
    PG8_STAGE(PG8_SB(0, 0), cB, voffB); PG8_STAGE(PG8_SA(0, 0), cA, voA[0]); PG8_STAGE(PG8_SB(0, 1), cB + hstep, voffB); PG8_STAGE(PG8_SA(0, 1), cA, voA[1]);
    if (wr == 1) PG8_BAR;
    PG8_WAIT_V(4); PG8_BAR;
    PG8_STAGE(PG8_SB(1, 0), cB + kstep, voffB); PG8_STAGE(PG8_SA(1, 0), cA + kstep, voA[0]); PG8_STAGE(PG8_SB(1, 1), cB + hstep + kstep, voffB);
    PG8_WAIT_V(6); PG8_BAR;
    for (;;) {
        E.prefetch(cur, ui, wid, lane);
        const bool has_next = S.next(ui + 1, nxt);
        const char* nA = has_next ? S.a_base(nxt) : cA; const char* nB = has_next ? S.b_base(nxt) : cB;
        unsigned rawN[2][2] = {{0u, 0u}, {0u, 0u}};
        if (Sched::DYN_AOFF) { if (has_next) S.a_raw(nxt, sR, rawN); }
#pragma unroll 1
        for (int t = 0; t < nt; t += 2) {
            const bool last = (t == nt - 2);
            const char* a1 = cA + (size_t)(t + 1) * kstep;
            const char* a2 = last ? nA : cA + (size_t)(t + 2) * kstep; const char* b2 = last ? nB : cB + (size_t)(t + 2) * kstep;
            const char* a3 = a2 + kstep; const char* b3 = b2 + kstep;
            unsigned v2[2][2];
#pragma unroll
            for (int h = 0; h < 2; ++h)
#pragma unroll
                for (int i = 0; i < 2; ++i) v2[h][i] = voA[h][i];
            if (Sched::DYN_AOFF && last) {
                asm volatile("" : "+v"(rawN[0][0]));
#pragma unroll
                for (int h = 0; h < 2; ++h)
#pragma unroll
                    for (int i = 0; i < 2; ++i) { voN[h][i] = has_next ? S.a_fin(rawN[h][i], sC[i]) : voA[h][i]; v2[h][i] = voN[h][i]; }
            }
            PG8_LDB(B0, 0, 0); PG8_SCHED; PG8_LDA(At, 0, 0); PG8_STAGE(PG8_SA(1, 1), a1, voA[1]);
            PG8_WAIT_L(8); PG8_BAR; PG8_WAIT_L(0); PG8_MMA(0, 0, At, B0); PG8_BAR; PG8_SCHED;
            PG8_LDB(B1, 0, 1); PG8_STAGE(PG8_SB(0, 0), b2, voffB);
            PG8_BAR; PG8_WAIT_L(0); PG8_MMA(0, 1, At, B1); PG8_BAR;
            PG8_LDA(At, 0, 1); PG8_STAGE(PG8_SA(0, 0), a2, v2[0]);
            PG8_BAR; PG8_WAIT_L(0); PG8_MMA(1, 0, At, B0); PG8_BAR; PG8_SCHED;
            PG8_STAGE(PG8_SB(0, 1), b2 + hstep, voffB);
            PG8_WAIT_V(6); PG8_BAR; PG8_MMA(1, 1, At, B1); PG8_BAR;
            PG8_LDB(B0, 1, 0); PG8_SCHED; PG8_LDA(At, 1, 0); PG8_STAGE(PG8_SA(0, 1), a2, v2[1]);
            PG8_WAIT_L(8); PG8_BAR; PG8_WAIT_L(0); PG8_MMA(0, 0, At, B0); PG8_BAR; PG8_SCHED;
            PG8_LDB(B1, 1, 1); PG8_STAGE(PG8_SB(1, 0), b3, voffB);
            PG8_BAR; PG8_WAIT_L(0); PG8_MMA(0, 1, At, B1); PG8_BAR;
            PG8_LDA(At, 1, 1); PG8_STAGE(PG8_SA(1, 0), a3, v2[0]);
            PG8_BAR; PG8_WAIT_L(0); PG8_MMA(1, 0, At, B0); PG8_BAR; PG8_SCHED;
            PG8_STAGE(PG8_SB(1, 1), b3 + hstep, voffB);
            PG8_WAIT_V(6); PG8_BAR; PG8_MMA(1, 1, At, B1); PG8_BAR;
        }
        if constexpr (Sched::FP8) asm volatile("s_nop 15\n\ts_nop 15\n\ts_nop 7" ::: "memory");
        E(acc, cur, ui, wr, wc, fr, fq);
        if (!has_next) break;
#pragma unroll
        for (int a = 0; a < 2; ++a)
#pragma unroll
            for (int b = 0; b < 2; ++b)
#pragma unroll
                for (int m = 0; m < 4; ++m)
#pragma unroll
                    for (int n = 0; n < 2; ++n) acc[a][b][m][n] = (f32x4){0.f, 0.f, 0.f, 0.f};
        cur = nxt; cA = nA; cB = nB; ++ui;
        if (Sched::DYN_AOFF) {
#pragma unroll
            for (int h = 0; h < 2; ++h)
#pragma unroll
                for (int i = 0; i < 2; ++i) voA[h][i] = voN[h][i];
        }
    }
    PG8_WAIT_V(0);
    if (wr == 0) PG8_BAR;
    PG8_BAR;
#undef PG8_SA
#undef PG8_SB
#undef PG8_STAGE
#undef PG8_LDA
#undef PG8_LD2
#undef PG8_LDB
#undef PG8_MMA
#undef PG8_WAIT_V
#undef PG8_WAIT_L
#undef PG8_BAR
#undef PG8_SCHED
}
}
using pg8::Unit;

template <bool INT8>
struct SchedDenseT {
    static constexpr bool DYN_AOFF = false, FP8 = false, I8 = INT8;
    const char* A; const char* Bt; int K, nM, nN, G, c, nextra, ex_pm0, ex_pn0, ex_nn;
    __device__ __forceinline__ bool next(int i, Unit& u) const {
        const int L = i * G + c; const int nwg = nM * nN;
        if (L < nwg) { int pm, pn; pg8::static_map(L, nM, nN, pm, pn);
            if (INT8) pn = (int)((0x9876BA325410ull >> (4 * pn)) & 15ull);
            u.pm = pm; u.pn = pn; u.e = 0; u.aux = 0; return true; }
        const int j = L - nwg; if (j >= nextra) return false;
        u.pm = ex_pm0 + j / ex_nn; u.pn = ex_pn0 + j % ex_nn; u.e = 0; u.aux = 0; return true;
    }
    __device__ __forceinline__ const char* a_base(const Unit& u) const { return A + (size_t)u.pm * 256 * K * 2; }
    __device__ __forceinline__ const char* b_base(const Unit& u) const { return Bt + (size_t)u.pn * 256 * K * 2; }
    __device__ __forceinline__ void a_raw(const Unit&, const int (&)[2], unsigned (&)[2][2]) const {}
    __device__ __forceinline__ unsigned a_fin(unsigned, int) const { return 0u; }
    __device__ __forceinline__ void a_off(const Unit&, const int (&sR)[2], const int (&sC)[2], unsigned (&vo)[2][2]) const {
#pragma unroll
        for (int h = 0; h < 2; ++h)
#pragma unroll
            for (int i = 0; i < 2; ++i) vo[h][i] = (unsigned)((h * 128 + sR[i]) * K + sC[i]) * 2u;
    }
};
template <bool GATHER>
struct SchedMoE {
    static constexpr bool DYN_AOFF = GATHER, FP8 = true, I8 = false;
    const char* A; const char* W; size_t wstride; int K, G, c; LAS const int* tab; const int* inv;
    int i_lo, i_hi;
    int l_first, l_count, l_stride;
    __device__ __forceinline__ bool next(int i, Unit& u) const {
        const int ci = c >> 3; int mt, pn;
        if (i_hi < 0) { if (i >= l_count) return false; const int idx = l_first + i * l_stride; mt = idx >> 2; pn = idx & 3; }
        else { const int ii = i + i_lo; if (ii >= i_hi) return false; mt = ii * (G >> 2) + (c & 7) * (G >> 5) + (ci >> 2); pn = ci & 3; }
        const int total = tab[32];
        if (mt >= total) return false;
        const int e = ((LAS const unsigned char*)tab)[384 + mt];
        u.pm = __builtin_amdgcn_readfirstlane(mt); u.pn = __builtin_amdgcn_readfirstlane(pn); u.e = __builtin_amdgcn_readfirstlane(e); u.aux = __builtin_amdgcn_readfirstlane(mt - tab[e]);
        return true;
    }
    __device__ __forceinline__ const char* a_base(const Unit& u) const { return GATHER ? A : A + (size_t)u.pm * 256 * K * 2; }
    __device__ __forceinline__ const char* b_base(const Unit& u) const { return W + (size_t)u.e * wstride + (size_t)u.pn * 256 * K * 2; }
    __device__ __forceinline__ void a_raw(const Unit& u, const int (&sR)[2], unsigned (&raw)[2][2]) const {
        const int cnt = tab[64 + u.e];
#pragma unroll
        for (int h = 0; h < 2; ++h)
#pragma unroll
            for (int i = 0; i < 2; ++i) { const int idx = u.aux * 256 + h * 128 + sR[i]; unsigned r = 0u; if (idx < cnt) r = (unsigned)inv[(size_t)u.e * NTOK + idx]; raw[h][i] = r; }
    }
    __device__ __forceinline__ unsigned a_fin(unsigned r, int sc) const { return ((r & 0xffffu) >> 1) * (unsigned)(K * 2) + (unsigned)sc * 2u; }
    __device__ __forceinline__ void a_off(const Unit& u, const int (&sR)[2], const int (&sC)[2], unsigned (&vo)[2][2]) const {
        if (GATHER) {
            const int cnt = tab[64 + u.e];
#pragma unroll
            for (int h = 0; h < 2; ++h)
#pragma unroll
                for (int i = 0; i < 2; ++i) {
                    const int idx = u.aux * 256 + h * 128 + sR[i];
                    int slot = 0; if (idx < cnt) slot = inv[(size_t)u.e * NTOK + idx] & 0xffff;
                    vo[h][i] = (unsigned)(slot >> 1) * (unsigned)(K * 2) + (unsigned)sC[i] * 2u;
                }
        } else {
#pragma unroll
            for (int h = 0; h < 2; ++h)
#pragma unroll
                for (int i = 0; i < 2; ++i) vo[h][i] = (unsigned)((h * 128 + sR[i]) * K + sC[i]) * 2u;
        }
    }
};

template <bool I8>
struct EpiPT {
    static constexpr bool PERM = true;
    bf16_t* P; const float* lbl; const float* sa; const float* cmax;
    LAS const float* lcm; LAS const float* llb;
    LAS float* lrs;
    __device__ __forceinline__ void prefetch(const Unit& u, int ui, int wid, int lane) const {
        if constexpr (I8) { if (wid < 4) __builtin_amdgcn_global_load_lds((const unsigned*)(sa + u.pm * 256 + wid * 64 + lane), (LAS unsigned*)(lrs + (ui & 1) * 256 + wid * 64), 4, 0, 0); }
    }
    template <int ACT>
    __device__ __forceinline__ void body(const f32x4 (&acc)[2][2][4][2], const Unit& u, int ui, int wr, int wc, int fr, int fq) const {
        const int row0 = u.pm * 256 + wr * 64 + fr;
        float rs[8];
        if constexpr (I8) {
#pragma unroll
            for (int i = 0; i < 8; ++i) rs[i] = lrs[(ui & 1) * 256 + wr * 64 + fr + (i >> 2) * 128 + (i & 3) * 16] * (1.0f / 127.0f);
        }
#pragma unroll
        for (int bj = 0; bj < 2; ++bj) {
            const int col0 = u.pn * 256 + bj * 128 + wc * 32 + 8 * fq;
            float lb[8], cs[8];
#pragma unroll
            for (int j = 0; j < 8; ++j) { lb[j] = 0.f; cs[j] = 1.0f; }
            if constexpr (I8) { const f32x4 c0 = *(LAS const f32x4*)(lcm + col0), c1 = *(LAS const f32x4*)(lcm + col0 + 4);
#pragma unroll
                for (int j = 0; j < 4; ++j) { cs[j] = c0[j]; cs[4 + j] = c1[j]; } }
            if constexpr (ACT == 2) {
                const int cc = col0 - 1536;
                if constexpr (I8) { const f32x4 b0 = *(LAS const f32x4*)(llb + cc), b1 = *(LAS const f32x4*)(llb + cc + 4);
#pragma unroll
                    for (int j = 0; j < 4; ++j) { lb[j] = b0[j]; lb[4 + j] = b1[j]; } }
                else { const int dir = cc >> 9, c2 = cc & 511;
#pragma unroll
                    for (int j = 0; j < 8; ++j) { const float l0 = lbl[dir * 1024 + c2 + j], l1 = lbl[dir * 1024 + 512 + c2 + j]; lb[j] = sigmoid_f(l0 - l1); } }
            }
#pragma unroll
            for (int ai = 0; ai < 2; ++ai)
#pragma unroll
                for (int m = 0; m < 4; ++m) {
                    float v[8];
#pragma unroll
                    for (int j = 0; j < 4; ++j) { v[j] = acc[ai][bj][m][0][j]; v[4 + j] = acc[ai][bj][m][1][j]; }
                    if constexpr (I8) {
                        const float r = rs[ai * 4 + m];
#pragma unroll
                        for (int j = 0; j < 8; ++j) v[j] = (float)__builtin_bit_cast(int, v[j]) * (r * cs[j]);
                    }
                    if constexpr (ACT == 1) {
#pragma unroll
                        for (int j = 0; j < 8; ++j) v[j] = silu_f(v[j]);
                    } else if constexpr (ACT == 2) {
#pragma unroll
                        for (int j = 0; j < 8; ++j) { const float f = lb[j] + (1.0f - lb[j]) * sigmoid_f(v[j]); v[j] = __builtin_amdgcn_logf(f); }
                    }
                    u32x4 w; w.x = cvt_pk_bf16(v[0], v[1]); w.y = cvt_pk_bf16(v[2], v[3]); w.z = cvt_pk_bf16(v[4], v[5]); w.w = cvt_pk_bf16(v[6], v[7]);
                    *(u32x4*)(P + p_off(col0 >> 7, row0 + ai * 128 + m * 16) + (col0 & 127)) = w;
                }
        }
    }
    __device__ __forceinline__ void operator()(const f32x4 (&acc)[2][2][4][2], const Unit& u, int ui, int wr, int wc, int fr, int fq) const {
        const int type = u.pn >> 1;
        if (type == 1 || type == 5) body<1>(acc, u, ui, wr, wc, fr, fq);
        else if (type == 3 || type == 4) body<2>(acc, u, ui, wr, wc, fr, fq);
        else body<0>(acc, u, ui, wr, wc, fr, fq);
    }
};
struct EpiX1 {
    static constexpr bool PERM = true;
    __device__ __forceinline__ void prefetch(const Unit&, int, int, int) const {}
    LAS const float* lga; bf16_t* out;
    __device__ __forceinline__ void operator()(const f32x4 (&acc)[2][2][4][2], const Unit& u, int, int wr, int wc, int fr, int fq) const {
        const int row0 = u.pm * 256 + wr * 64 + fr;
        const int b = (u.pm * 256) / SEQ;
#pragma unroll
        for (int bj = 0; bj < 2; ++bj) {
            const int col0 = u.pn * 256 + bj * 128 + wc * 32 + 8 * fq;
            const f32x4 g0 = *(LAS const f32x4*)(lga + b * 1024 + col0), g1 = *(LAS const f32x4*)(lga + b * 1024 + col0 + 4);
#pragma unroll
            for (int ai = 0; ai < 2; ++ai)
#pragma unroll
                for (int m = 0; m < 4; ++m) {
                    const f32x4 a0 = acc[ai][bj][m][0] * g0, a1 = acc[ai][bj][m][1] * g1;
                    u32x4 w; w.x = cvt_pk_bf16(a0[0], a0[1]); w.y = cvt_pk_bf16(a0[2], a0[3]); w.z = cvt_pk_bf16(a1[0], a1[1]); w.w = cvt_pk_bf16(a1[2], a1[3]);
                    *(u32x4*)(out + (size_t)(row0 + ai * 128 + m * 16) * DM + col0) = w;
                }
        }
    }
};
struct EpiH {
    static constexpr bool PERM = true;
    __device__ __forceinline__ void prefetch(const Unit&, int, int, int) const {}
    bf16_t* H;
    __device__ __forceinline__ void operator()(const f32x4 (&acc)[2][2][4][2], const Unit& u, int, int wr, int wc, int fr, int fq) const {
        const int row0 = u.pm * 256 + wr * 64 + fr, col0 = u.pn * 128 + wc * 32 + 8 * fq;
#pragma unroll
        for (int ai = 0; ai < 2; ++ai)
#pragma unroll
            for (int m = 0; m < 4; ++m) {
                float v[8];
#pragma unroll
                for (int j = 0; j < 4; ++j) { v[j] = silu_f(acc[ai][0][m][0][j] * W8_INV) * (acc[ai][1][m][0][j] * W8_INV); v[4 + j] = silu_f(acc[ai][0][m][1][j] * W8_INV) * (acc[ai][1][m][1][j] * W8_INV); }
                u32x2 w; w.x = pk4_fp8(v[0], v[1], v[2], v[3]); w.y = pk4_fp8(v[4], v[5], v[6], v[7]);
                *(u32x2*)((unsigned char*)H + (size_t)(row0 + ai * 128 + m * 16) * DE + col0) = w;
            }
    }
};
struct EpiY {
    static constexpr bool PERM = true;
    unsigned char* Y; const int* inv; LAS const int* tab;
    LAS unsigned* lpe;
    __device__ __forceinline__ void prefetch(const Unit& u, int ui, int wid, int lane) const {
        if (wid < 4) __builtin_amdgcn_global_load_lds((const unsigned*)(inv + (size_t)u.e * NTOK + u.aux * 256 + wid * 64 + lane), (LAS unsigned*)(lpe + (ui & 1) * 256 + wid * 64), 4, 0, 0);
    }
    __device__ __forceinline__ void operator()(const f32x4 (&acc)[2][2][4][2], const Unit& u, int ui, int wr, int wc, int fr, int fq) const {
        const int cnt = tab[64 + u.e];
        const int col0 = u.pn * 256 + wc * 32 + 8 * fq;
#pragma unroll
        for (int ai = 0; ai < 2; ++ai)
#pragma unroll
            for (int m = 0; m < 4; ++m) {
                const int ridx = wr * 64 + fr + ai * 128 + m * 16;
                if (u.aux * 256 + ridx < cnt) {
                    const unsigned ent = lpe[(ui & 1) * 256 + ridx];
                    const int slot = (int)(ent & 0xffffu); const float g = bf2f(ent >> 16) * (W8_INV * Y8_SCALE);
#pragma unroll
                    for (int bj = 0; bj < 2; ++bj) {
                        const f32x4 a0 = acc[ai][bj][m][0] * g, a1 = acc[ai][bj][m][1] * g;
                        u32x2 w; w.x = pk4_fp8(a0[0], a0[1], a0[2], a0[3]); w.y = pk4_fp8(a1[0], a1[1], a1[2], a1[3]);
                        *(u32x2*)((unsigned char*)Y + (size_t)slot * DM + col0 + bj * 128) = w;
                    }
                }
            }
    }
};

__device__ __forceinline__ void transpose_item(const float* W, int Nsrc, int k0, int n0, bf16_t* WT, int ld, int row0, const float* scale, LAS float* scr, int lane, unsigned* cmax, bool wr_bf) {
    { float t[32];
#pragma unroll
      for (int i = 0; i < 32; ++i) { const int kk = 2 * i + (lane >> 5); t[i] = NT_LD(W + (size_t)(k0 + kk) * Nsrc + n0 + (lane & 31)); }
#pragma unroll
      for (int i = 0; i < 32; ++i) { const int kk = 2 * i + (lane >> 5); scr[kk * 33 + (lane & 31)] = t[i]; } }
    asm volatile("s_waitcnt lgkmcnt(0)" ::: "memory");
    const int c = lane & 7;
#pragma unroll
    for (int j = 0; j < 4; ++j) {
        const int n = (lane >> 3) + 8 * j; const LAS float* s = scr + (8 * c) * 33 + n;
        const float sc = scale ? scale[n] : 1.0f;
        u32x4 o; o.x = cvt_pk_bf16(s[0 * 33] * sc, s[1 * 33] * sc); o.y = cvt_pk_bf16(s[2 * 33] * sc, s[3 * 33] * sc); o.z = cvt_pk_bf16(s[4 * 33] * sc, s[5 * 33] * sc); o.w = cvt_pk_bf16(s[6 * 33] * sc, s[7 * 33] * sc);
        if (wr_bf) *(u32x4*)(WT + (size_t)(row0 + n) * ld + k0 + 8 * c) = o;
        if (cmax) {
            float m = fmaxf(fmaxf(fmaxf(fabsf(s[0 * 33]), fabsf(s[1 * 33])), fmaxf(fabsf(s[2 * 33]), fabsf(s[3 * 33]))), fmaxf(fmaxf(fabsf(s[4 * 33]), fabsf(s[5 * 33])), fmaxf(fabsf(s[6 * 33]), fabsf(s[7 * 33]))));
            m = fmaxf(m, __shfl_xor(m, 1)); m = fmaxf(m, __shfl_xor(m, 2)); m = fmaxf(m, __shfl_xor(m, 4));
            if (c == 0) atomicMax(cmax + n0 + n, __float_as_uint(m));
        }
    }
    asm volatile("s_waitcnt lgkmcnt(0)" ::: "memory");
}

struct TItem { const float* W; bf16_t* WT; const float* scale; int Nsrc, k0, n0, ld, row0; int fp8; };
__device__ __forceinline__ void titem_emit(const TItem& T, const LAS float* q, int n, int c) {
    if (T.fp8 == 1) { u32x2 o8; o8.x = pk4_fp8(q[0 * 33] * W8_SCALE, q[1 * 33] * W8_SCALE, q[2 * 33] * W8_SCALE, q[3 * 33] * W8_SCALE); o8.y = pk4_fp8(q[4 * 33] * W8_SCALE, q[5 * 33] * W8_SCALE, q[6 * 33] * W8_SCALE, q[7 * 33] * W8_SCALE);
        NT_ST(o8, (u32x2*)((unsigned char*)T.WT + (size_t)(T.row0 + n) * T.ld + T.k0 + 8 * c)); }
    else if (T.fp8 == 2) { const float am = T.scale[n]; const float iv = am > 0.f ? 127.0f / am : 0.f;
        u32x2 o8; o8.x = pk4_i8(q[0 * 33] * iv, q[1 * 33] * iv, q[2 * 33] * iv, q[3 * 33] * iv); o8.y = pk4_i8(q[4 * 33] * iv, q[5 * 33] * iv, q[6 * 33] * iv, q[7 * 33] * iv);
        *(u32x2*)((unsigned char*)T.WT + (size_t)(T.row0 + n) * T.ld + T.k0 + 8 * c) = o8; }
    else { const float sc = T.scale ? T.scale[n] : 1.0f;
        u32x4 o; o.x = cvt_pk_bf16(q[0 * 33] * sc, q[1 * 33] * sc); o.y = cvt_pk_bf16(q[2 * 33] * sc, q[3 * 33] * sc); o.z = cvt_pk_bf16(q[4 * 33] * sc, q[5 * 33] * sc); o.w = cvt_pk_bf16(q[6 * 33] * sc, q[7 * 33] * sc);
        NT_ST(o, (u32x4*)(T.WT + (size_t)(T.row0 + n) * T.ld + T.k0 + 8 * c)); }
}
__device__ __forceinline__ void transpose_pair(const TItem& A, const TItem& B, bool hasB, LAS float* scr, int lane) {
    float va[32], vb[32];
#pragma unroll
    for (int i = 0; i < 32; ++i) { const int kk = 2 * i + (lane >> 5); va[i] = NT_LD(A.W + (size_t)(A.k0 + kk) * A.Nsrc + A.n0 + (lane & 31)); }
    if (hasB) {
#pragma unroll
        for (int i = 0; i < 32; ++i) { const int kk = 2 * i + (lane >> 5); vb[i] = NT_LD(B.W + (size_t)(B.k0 + kk) * B.Nsrc + B.n0 + (lane & 31)); }
    }
    const int c = lane & 7;
#pragma unroll
    for (int i = 0; i < 32; ++i) { const int kk = 2 * i + (lane >> 5); scr[kk * 33 + (lane & 31)] = va[i]; }
    asm volatile("s_waitcnt lgkmcnt(0)" ::: "memory");
#pragma unroll
    for (int j = 0; j < 4; ++j) {
        const int n = (lane >> 3) + 8 * j; const LAS float* q = scr + (8 * c) * 33 + n;
        titem_emit(A, q, n, c);
    }
    asm volatile("s_waitcnt lgkmcnt(0)" ::: "memory");
    if (hasB) {
#pragma unroll
        for (int i = 0; i < 32; ++i) { const int kk = 2 * i + (lane >> 5); scr[kk * 33 + (lane & 31)] = vb[i]; }
        asm volatile("s_waitcnt lgkmcnt(0)" ::: "memory");
#pragma unroll
        for (int j = 0; j < 4; ++j) {
            const int n = (lane >> 3) + 8 * j; const LAS float* q = scr + (8 * c) * 33 + n;
            titem_emit(B, q, n, c);
        }
        asm volatile("s_waitcnt lgkmcnt(0)" ::: "memory");
    }
}
constexpr int TI_W8 = 16 * 96, TI_O = 16 * 32, TI_13 = 2 * NE * 16 * 16, TI_2 = NE * 8 * 32, TI_P = 4 * 2 * 4, TI_ALL = TI_W8 + TI_O + TI_13 + TI_2 + TI_P;
__device__ __forceinline__ TItem decode_titem(const Params& p, int r) {
    TItem t; t.scale = nullptr; t.fp8 = 0;
    if (r < TI_W8) { const int kb = r / 96, nb = r % 96; t.W = p.w_in; t.Nsrc = DIN; t.k0 = kb * 64; t.n0 = nb * 32; t.WT = (bf16_t*)(p.ws + WS_WINT8); t.ld = DM; t.row0 = nb * 32; t.fp8 = 2; t.scale = (const float*)(p.ws + WS_CMAX) + nb * 32; return t; } r -= TI_W8;
    if (r < TI_O) { const int kb = r / 32, nb = r % 32; t.W = p.w_out; t.Nsrc = DM; t.k0 = kb * 64; t.n0 = nb * 32; t.WT = (bf16_t*)(p.ws + WS_WOUTT); t.ld = DM; t.row0 = nb * 32; return t; } r -= TI_O;
    if (r < TI_13) { const int which = r / (NE * 256); const int rr = r % (NE * 256); const int e = rr / 256, q = rr % 256, kb = q / 16, nb = q % 16; const int n0 = nb * 32;
        t.W = (which ? p.w3 : p.w1) + (size_t)e * DM * DE; t.Nsrc = DE; t.k0 = kb * 64; t.n0 = n0; t.WT = (bf16_t*)(p.ws + WS_W13T + (size_t)e * 1024 * 1024); t.ld = DM; t.fp8 = 1; t.row0 = (n0 >> 7) * 256 + which * 128 + (n0 & 127); return t; } r -= TI_13;
    if (r < TI_2) { const int e = r / 256, q = r % 256, kb = q / 32, nb = q % 32; t.W = p.w2 + (size_t)e * DE * DM; t.Nsrc = DM; t.k0 = kb * 64; t.n0 = nb * 32; t.WT = (bf16_t*)(p.ws + WS_W2T + (size_t)e * 1024 * 512); t.ld = DE; t.fp8 = 1; t.row0 = nb * 32; return t; } r -= TI_2;
    { const int g = r / 8, q = r % 8, kb = q / 4, nb = q % 4; t.W = p.w_pool + (size_t)g * 128 * 128; t.Nsrc = 128; t.k0 = kb * 64; t.n0 = nb * 32; t.WT = (bf16_t*)(p.ws + WS_WPT) + (size_t)g * 128 * 128; t.ld = 128; t.row0 = nb * 32; t.scale = p.s_pool + g * 128 + nb * 32; return t; }
}
template <int NR>
__device__ __forceinline__ void hx_rows(const Params& p, const float* mod, bf16_t* HX, int r0, int lane) {
    const float* xr0; int c;
    if (r0 < NTOK) { xr0 = p.x + (size_t)r0 * DM; c = r0 / SEQ; } else { xr0 = p.ctx + (size_t)(r0 - NTOK) * DM; c = 4; }
    f32x4 v[NR][4]; float s[NR];
#pragma unroll
    for (int u = 0; u < NR; ++u)
#pragma unroll
        for (int j = 0; j < 4; ++j) v[u][j] = NT_LD((const f32x4*)(xr0 + (size_t)u * DM + 4 * lane + 256 * j));
#pragma unroll
    for (int u = 0; u < NR; ++u) { s[u] = 0.f;
#pragma unroll
        for (int j = 0; j < 4; ++j) s[u] += (v[u][j][0] * v[u][j][0] + v[u][j][1] * v[u][j][1]) + (v[u][j][2] * v[u][j][2] + v[u][j][3] * v[u][j][3]); }
    float rstd[NR];
#pragma unroll
    for (int u = 0; u < NR; ++u) rstd[u] = rsqrtf(wave_sum(s[u]) * (1.0f / DM) + EPS);
#pragma unroll
    for (int j = 0; j < 4; ++j) {
        const int col = 4 * lane + 256 * j;
        const f32x4 g = *(const f32x4*)(p.g_mix + col), sh = *(const f32x4*)(mod + c * 6144 + col), scl = *(const f32x4*)(mod + c * 6144 + 1024 + col);
#pragma unroll
        for (int u = 0; u < NR; ++u) {
            f32x4 o;
#pragma unroll
            for (int q = 0; q < 4; ++q) o[q] = v[u][j][q] * rstd[u] * g[q] * (1.0f + scl[q]) + sh[q];
            u32x2 w; w.x = cvt_pk_bf16(o[0], o[1]); w.y = cvt_pk_bf16(o[2], o[3]);
            *(u32x2*)(HX + (size_t)(r0 + u) * DM + col) = w;
        }
    }
}
template <int NR>
__device__ __forceinline__ void hx_rows8(const Params& p, LAS const float* lg, LAS const float* lmod, unsigned char* HX8, float* SA, int r0, int lane) {
    const float* xr0; int c;
    if (r0 < NTOK) { xr0 = p.x + (size_t)r0 * DM; c = r0 / SEQ; } else { xr0 = p.ctx + (size_t)(r0 - NTOK) * DM; c = 4; }
    f32x4 v[NR][4]; float s[NR];
#pragma unroll
    for (int u = 0; u < NR; ++u)
#pragma unroll
        for (int j = 0; j < 4; ++j) v[u][j] = NT_LD((const f32x4*)(xr0 + (size_t)u * DM + 4 * lane + 256 * j));
#pragma unroll
    for (int u = 0; u < NR; ++u) { s[u] = 0.f;
#pragma unroll
        for (int j = 0; j < 4; ++j) s[u] += (v[u][j][0] * v[u][j][0] + v[u][j][1] * v[u][j][1]) + (v[u][j][2] * v[u][j][2] + v[u][j][3] * v[u][j][3]); }
    float rstd[NR], am[NR];
#pragma unroll
    for (int u = 0; u < NR; ++u) { rstd[u] = rsqrtf(wave_sum(s[u]) * (1.0f / DM) + EPS); am[u] = 0.f; }
#pragma unroll
    for (int j = 0; j < 4; ++j) {
        const int col = 4 * lane + 256 * j;
        const f32x4 g = *(const LAS f32x4*)(lg + col), sh = *(const LAS f32x4*)(lmod + c * 2048 + col), scl = *(const LAS f32x4*)(lmod + c * 2048 + 1024 + col);
#pragma unroll
        for (int u = 0; u < NR; ++u)
#pragma unroll
            for (int q = 0; q < 4; ++q) { const float o = v[u][j][q] * rstd[u] * g[q] * scl[q] + sh[q]; v[u][j][q] = o; am[u] = fmaxf(am[u], fabsf(o)); }
    }
#pragma unroll
    for (int u = 0; u < NR; ++u) {
        const float a = wave_max(am[u]); const float iv = a > 0.f ? 127.0f / a : 0.f;
        if (lane == 0) SA[r0 + u] = a * (1.0f / 127.0f);
#pragma unroll
        for (int j = 0; j < 4; ++j) *(unsigned*)(HX8 + (size_t)(r0 + u) * DM + 4 * lane + 256 * j) = pk4_i8(v[u][j][0] * iv, v[u][j][1] * iv, v[u][j][2] * iv, v[u][j][3] * iv);
    }
}
struct SchedOne {
    static constexpr bool DYN_AOFF = false, FP8 = false, I8 = false;
    const char* A; const char* Bt; int K, pm, pn;
    __device__ __forceinline__ bool next(int i, Unit& u) const { if (i > 0) return false; u.pm = pm; u.pn = pn; u.e = 0; u.aux = 0; return true; }
    __device__ __forceinline__ const char* a_base(const Unit& u) const { return A + (size_t)u.pm * 256 * K * 2; }
    __device__ __forceinline__ const char* b_base(const Unit& u) const { return Bt + (size_t)u.pn * 256 * K * 2; }
    __device__ __forceinline__ void a_raw(const Unit&, const int (&)[2], unsigned (&)[2][2]) const {}
    __device__ __forceinline__ unsigned a_fin(unsigned, int) const { return 0u; }
    __device__ __forceinline__ void a_off(const Unit&, const int (&sR)[2], const int (&sC)[2], unsigned (&vo)[2][2]) const {
#pragma unroll
        for (int h = 0; h < 2; ++h)
#pragma unroll
            for (int i = 0; i < 2; ++i) vo[h][i] = (unsigned)((h * 128 + sR[i]) * K + sC[i]) * 2u;
    }
};

__device__ __forceinline__ void phase0(const Params& p, LAS unsigned char* lds) {
    const int tid = threadIdx.x, lane = tid & 63, wave = tid >> 6, G = gridDim.x;
    int* ctl = (int*)(p.ws + WS_CTL);
    if (blockIdx.x == 0) ctl[tid] = 0;
    float* mod = (float*)(p.ws + WS_MOD);
    LAS float* sc = (LAS float*)lds;
    LAS float* red = sc + 5 * 1024;
    bool did = false;
    for (int item = blockIdx.x; item < 192; item += G) {
        if (!did) {
            { float t[10];
#pragma unroll
              for (int q = 0; q < 10; ++q) { const int i = tid + 512 * q, c = i >> 10, k = i & 1023; t[q] = (c < 4) ? p.c[c * 1024 + k] : p.c_ctx[k]; }
#pragma unroll
              for (int q = 0; q < 10; ++q) { const float v = t[q]; sc[tid + 512 * q] = v / (1.0f + expf(-v)); } }
            __syncthreads(); did = true;
        }
        const int cl = tid & 31, kg = tid >> 5, col = item * 32 + cl;
        float a0 = 0.f, a1 = 0.f, a2 = 0.f, a3 = 0.f, a4 = 0.f;
#pragma unroll 32
        for (int kk = 0; kk < 64; ++kk) { const int k = kg * 64 + kk; const float w = NT_LD(p.w_ada + (size_t)k * 6144 + col);
            a0 += sc[k] * w; a1 += sc[1024 + k] * w; a2 += sc[2048 + k] * w; a3 += sc[3072 + k] * w; a4 += sc[4096 + k] * w; }
        red[(kg * 5 + 0) * 32 + cl] = a0; red[(kg * 5 + 1) * 32 + cl] = a1; red[(kg * 5 + 2) * 32 + cl] = a2; red[(kg * 5 + 3) * 32 + cl] = a3; red[(kg * 5 + 4) * 32 + cl] = a4;
        __syncthreads();
        if (tid < 160) { const int c = tid >> 5, l = tid & 31; float s = 0.f; for (int g = 0; g < 16; ++g) s += red[(g * 5 + c) * 32 + l]; mod[c * 6144 + item * 32 + l] = s + p.b_ada[item * 32 + l]; }
        __syncthreads();
    }
    __syncthreads();
    LAS float* scr = (LAS float*)(lds + 32768 + wave * 8448);
    const int gw = blockIdx.x * 8 + wave, NW = G * 8;
    bf16_t* WinT = (bf16_t*)(p.ws + WS_WINT);
    unsigned* cmax = (unsigned*)(p.ws + WS_CMAX);
    for (int it = gw; it < 16 * 96; it += NW) { const int kb = it / 96, nb = it % 96;
        transpose_item(p.w_in, DIN, kb * 64, nb * 32, WinT, DM, nb * 32, nullptr, scr, lane, cmax, nb >= 32 && nb < 80); }
}

__device__ __forceinline__ void phase1(const Params& p, LAS unsigned char* lds) {
    const int tid = threadIdx.x, lane = tid & 63, wave = tid >> 6, G = gridDim.x;
    const float* mod = (const float*)(p.ws + WS_MOD);
    bf16_t* HX = (bf16_t*)(p.ws + WS_HXC) - (size_t)NTOK * DM;
    unsigned char* HX8 = (unsigned char*)(p.ws + WS_HX); float* SA = (float*)(p.ws + WS_SA);
    const int nctx = (G > 48) ? 24 : 0;
    if ((int)blockIdx.x < nctx) {
        const int pm = NTOK / 256 + blockIdx.x / 6, pn = 4 + blockIdx.x % 6;
        for (int i = 0; i < 8; ++i) hx_rows<4>(p, mod, HX, pm * 256 + wave * 32 + 4 * i, lane);
        asm volatile("s_waitcnt vmcnt(0)" ::: "memory");
        __syncthreads();
        SchedOne S; S.A = (const char*)HX; S.Bt = (const char*)(p.ws + WS_WINT); S.K = DM; S.pm = pm; S.pn = pn;
        EpiPT<false> E; E.P = (bf16_t*)(p.ws + WS_P); E.lbl = p.lb_logits; E.sa = nullptr; E.cmax = nullptr; E.lcm = nullptr; E.llb = nullptr; E.lrs = nullptr; pg8::gemm_phase(lds, DM, S, E);
        return;
    }
    const int gw = (blockIdx.x - nctx) * 8 + wave, NW = (G - nctx) * 8;
    const int nrows = nctx ? NTOK : MROWS;
    LAS float* lg = (LAS float*)(lds + 69632); LAS float* lmod = lg + 1024;
    { const float t0 = p.g_mix[tid], t1 = p.g_mix[tid + 512]; lg[tid] = t0; lg[tid + 512] = t1; }
    { float t[20];
#pragma unroll
      for (int q = 0; q < 20; ++q) { const int i = tid + 512 * q, cc = i >> 11, r = i & 2047; t[q] = mod[cc * 6144 + r]; }
#pragma unroll
      for (int q = 0; q < 20; ++q) { const int i = tid + 512 * q, r = i & 2047; lmod[i] = (r < 1024) ? t[q] : 1.0f + t[q]; } }
    __syncthreads();
    for (int pr = gw; pr < nrows / 2; pr += NW) hx_rows8<2>(p, lg, lmod, HX8, SA, 2 * pr, lane);
    LAS float* scr = (LAS float*)(lds + wave * 8448);
    for (int it = gw; it < TI_ALL; it += 2 * NW) {
        const TItem A = decode_titem(p, it); const bool hasB = (it + NW) < TI_ALL; const TItem B = decode_titem(p, hasB ? it + NW : it);
        transpose_pair(A, B, hasB, scr, lane);
    }
}

__device__ __forceinline__ int scan_row(int b, int dir, int j, int t) {
    if (j < NSC) { const int pos = j * SCL + t; const int n = dir ? (SEQ - 1 - pos) : pos; return b * SEQ + n; }
    const int n = dir ? (CTXL - 1 - t) : t; return NTOK + b * CTXL + n;
}
typedef short s16x4 __attribute__((ext_vector_type(4)));
__device__ __forceinline__ unsigned off_b(unsigned row, unsigned ch) { return 256u * row + 16u * (ch ^ (((row & 3u) << 2) | ((row >> 2) & 3u))); }
struct FragBase { unsigned rowb[4]; unsigned tr_row0, tr_row1, tr_y0, tr_y1; };
__device__ __forceinline__ FragBase make_frag_base(int lane) {
    FragBase F; const unsigned l15 = lane & 15, g4 = lane >> 4, q = l15 >> 2, pp = lane & 3;
    const unsigned y = g4 ^ (((l15 & 3u) << 2) | (l15 >> 2));
#pragma unroll
    for (int sI = 0; sI < 4; ++sI) F.rowb[sI] = 256u * l15 + ((64u * sI) ^ (16u * y));
    const unsigned x0 = ((q & 3u) << 2) | ((2u * g4) & 3u), x1 = ((q & 3u) << 2) | ((2u * g4 + 1u) & 3u);
    F.tr_y0 = 16u * (x0 ^ (pp >> 1)); F.tr_y1 = 16u * (x1 ^ (pp >> 1));
    F.tr_row0 = 256u * (8u * g4 + q) + 8u * (pp & 1u); F.tr_row1 = F.tr_row0 + 1024u;
    return F;
}
__device__ __forceinline__ bf16x8 row_frag(LAS unsigned char* tile, const FragBase& F, int rb, int sI) { return *(const LAS bf16x8*)(tile + F.rowb[sI] + 4096u * rb); }
__device__ __forceinline__ bf16x8 tr_frag(LAS unsigned char* tile, const FragBase& F, int c, int ks) {
    const s16x4 r0 = __builtin_amdgcn_ds_read_tr16_b64_v4i16((LAS s16x4*)(tile + (F.tr_row0 + ((32u * c) ^ F.tr_y0)) + 8192u * ks));
    const s16x4 r1 = __builtin_amdgcn_ds_read_tr16_b64_v4i16((LAS s16x4*)(tile + (F.tr_row1 + ((32u * c) ^ F.tr_y1)) + 8192u * ks));
    return __builtin_shufflevector(r0, r1, 0, 1, 2, 3, 4, 5, 6, 7);
}
__device__ __forceinline__ float clamp80(float x) { return __builtin_amdgcn_fmed3f(x, -115.0f, 115.0f); }

constexpr int HG_OF = 92672;
template <int MODE>
__device__ __forceinline__ void hgrn_body(const Params& p, LAS unsigned char* lds, const int b, const int h, const int dir, const int j, const int lane, const int w) {
    constexpr bool OUT = (MODE != 0);
    const int g4 = lane >> 4, l15 = lane & 15;
    const FragBase FB = make_frag_base(lane);
    LAS unsigned char* QD = lds; LAS unsigned char* KD = lds + 16384; LAS unsigned char* VV = lds + 32768; LAS unsigned char* SP = lds + 49152; LAS unsigned char* PP = lds + 81920;
    LAS float* TOT = (LAS float*)(lds + 81920); LAS float* VEC = (LAS float*)(lds + 91136);
    LAS unsigned char* OF = lds + HG_OF; LAS float* RS = (LAS float*)(lds + LDS_TAB + 1024);
    const bf16_t* P = (const bf16_t*)(p.ws + WS_P);
    bf16_t* SL = (bf16_t*)(p.ws + WS_SL); float* DL = (float*)(p.ws + WS_DL);
    bf16_t* A2 = (bf16_t*)(p.ws + WS_A2);
    const int scan = (b * 4 + h) * 2 + dir;
    bf16_t* sl = SL + (size_t)(scan * (NSC + 1) + j) * 16384;
    const int vp = w >> 1, dh = w & 1;
    f32x4 st[8];
#pragma unroll
    for (int k = 0; k < 8; ++k) {
        const int di = 4 * dh + (k & 3), vt = 2 * vp + (k >> 2);
        if (OUT) { const u32x2 u = *(const u32x2*)(sl + (size_t)(16 * di + l15) * 128 + 16 * vt + 4 * g4); st[k] = (f32x4){bf2f(u.x & 0xffffu), bf2f(u.x >> 16), bf2f(u.y & 0xffffu), bf2f(u.y >> 16)}; }
        else st[k] = (f32x4){0.f, 0.f, 0.f, 0.f};
    }
    float lsum0 = 0.f, lsum1 = 0.f;
    f32x4 gh = (f32x4){0.f, 0.f, 0.f, 0.f};
    if (MODE == 2) gh = *(const f32x4*)(p.g_hnorm + 16 * w + 4 * g4);
    f32x4 oxk[4]; u32x2 gtk[4];
    unsigned lfw[8], vw[8], qw[8];
#define HG_LOAD(cc) do { _Pragma("unroll") for (int i = 0; i < 8; ++i) { \
            const int row_ = scan_row(b, dir, j, (cc) * 64 + 8 * w + i); \
            lfw[i] = NT_LD((const unsigned*)(P + p_off(12 + dir * 4 + h, row_) + 2 * lane)); vw[i] = NT_LD((const unsigned*)(P + p_off(8 + h, row_) + 2 * lane)); \
            if (OUT) qw[i] = NT_LD((const unsigned*)(P + p_off(4 + h, row_) + 2 * lane)); else qw[i] = 0u; } } while (0)
    HG_LOAD(0);
#pragma unroll 1
    for (int c = 0; c < SCL / 64; ++c) {
        float fg0[8], fg1[8]; float r0 = 0.f, r1 = 0.f;
#pragma unroll
        for (int i = 0; i < 8; ++i) { const float l0 = bf2f(lfw[i] & 0xffffu), l1 = bf2f(lfw[i] >> 16); r0 += l0; r1 += l1; fg0[i] = ex2(l0); fg1[i] = ex2(l1); }
        *(LAS f32x2*)(TOT + w * 128 + 2 * lane) = (f32x2){r0, r1};
        __syncthreads();
        float pre0 = 0.f, pre1 = 0.f, bm0 = 0.f, bm1 = 0.f, bt0 = 0.f, bt1 = 0.f;
#pragma unroll
        for (int ww = 0; ww < 8; ++ww) { const f32x2 tt = *(const LAS f32x2*)(TOT + ww * 128 + 2 * lane);
            if (ww < w) { pre0 += tt[0]; pre1 += tt[1]; } if (ww < 4) { bm0 += tt[0]; bm1 += tt[1]; } bt0 += tt[0]; bt1 += tt[1]; }
        {
            float e0 = ex2(clamp80(bm0 - (pre0 + r0))), e1 = ex2(clamp80(bm1 - (pre1 + r1)));
#pragma unroll
            for (int i = 7; i >= 0; --i) {
                const unsigned t = 8 * w + i; const unsigned a = off_b(t, (unsigned)(lane >> 2)) + 4u * (lane & 3);
                const float n0 = fg0[i] * e0, n1 = fg1[i] * e1;
                *(LAS unsigned*)(KD + a) = cvt_pk_bf16(e0 - n0, e1 - n1);
                *(LAS unsigned*)(VV + a) = vw[i];
                e0 = n0; e1 = n1;
            }
            if (OUT) {
                float g0 = ex2(clamp80(pre0 - bm0)), g1 = ex2(clamp80(pre1 - bm1));
#pragma unroll
                for (int i = 0; i < 8; ++i) {
                    const unsigned t = 8 * w + i; const unsigned a = off_b(t, (unsigned)(lane >> 2)) + 4u * (lane & 3);
                    g0 *= fg0[i]; g1 *= fg1[i];
                    *(LAS unsigned*)(QD + a) = cvt_pk_bf16(bf2f(qw[i] & 0xffffu) * g0, bf2f(qw[i] >> 16) * g1);
                }
            }
        }
        if (w == 0) {
            *(LAS f32x2*)(VEC + 2 * lane) = (f32x2){ex2(bm0), ex2(bm1)};
            *(LAS f32x2*)(VEC + 128 + 2 * lane) = (f32x2){ex2(bt0), ex2(bt1)};
            *(LAS f32x2*)(VEC + 256 + 2 * lane) = (f32x2){ex2(bt0 - bm0), ex2(bt1 - bm1)};
        }
        lsum0 += bt0; lsum1 += bt1;
        __syncthreads();
        if (c + 1 < SCL / 64) HG_LOAD(c + 1);
        bf16x8 Vt2[2][2];
#pragma unroll
        for (int vv = 0; vv < 2; ++vv) { Vt2[vv][0] = tr_frag(VV, FB, 2 * vp + vv, 0); Vt2[vv][1] = tr_frag(VV, FB, 2 * vp + vv, 1); }
        bf16x8 Vt[2]; Vt[0] = dh ? Vt2[1][0] : Vt2[0][0]; Vt[1] = dh ? Vt2[1][1] : Vt2[0][1];
        if (OUT) {
#pragma unroll
            for (int k = 0; k < 8; ++k) {
                const int di = 4 * dh + (k & 3), vt = 2 * vp + (k >> 2);
                const int d = 16 * di + l15; const float e = VEC[d];
                u32x2 o; o.x = cvt_pk_bf16(e * st[k][0], e * st[k][1]); o.y = cvt_pk_bf16(e * st[k][2], e * st[k][3]);
                *(LAS u32x2*)(SP + off_b((unsigned)d, (unsigned)(2 * vt + (g4 >> 1))) + 8u * (g4 & 1)) = o;
            }
            const int ti = w >> 1;
#pragma unroll
            for (int sx = 0; sx < 2; ++sx) {
                const int si = 2 * (w & 1) + sx;
                f32x4 a = (f32x4){0.f, 0.f, 0.f, 0.f};
                if (si <= ti) {
#pragma unroll
                    for (int ks = 0; ks < 4; ++ks) a = __builtin_amdgcn_mfma_f32_16x16x32_bf16(row_frag(KD, FB, si, ks), row_frag(QD, FB, ti, ks), a, 0, 0, 0);
                }
                const int tt = 16 * ti + l15, s0 = 16 * si + 4 * g4;
                u32x2 o; o.x = cvt_pk_bf16(s0 + 0 <= tt ? a[0] : 0.f, s0 + 1 <= tt ? a[1] : 0.f); o.y = cvt_pk_bf16(s0 + 2 <= tt ? a[2] : 0.f, s0 + 3 <= tt ? a[3] : 0.f);
                *(LAS u32x2*)(PP + tt * 144 + s0 * 2) = o;
            }
            __syncthreads();
            bf16x8 St[4];
#pragma unroll
            for (int ks = 0; ks < 4; ++ks) St[ks] = tr_frag(SP, FB, w, ks);
#pragma unroll
            for (int ti2 = 0; ti2 < 4; ++ti2) {
                f32x4 oa = (f32x4){0.f, 0.f, 0.f, 0.f};
#pragma unroll
                for (int ks = 0; ks < 2; ++ks) { const bf16x8 pf = *(const LAS bf16x8*)(PP + (16 * ti2 + l15) * 144 + (32 * ks + 8 * g4) * 2); oa = __builtin_amdgcn_mfma_f32_16x16x32_bf16(Vt[ks], pf, oa, 0, 0, 0); }
#pragma unroll
                for (int ks = 0; ks < 4; ++ks) oa = __builtin_amdgcn_mfma_f32_16x16x32_bf16(St[ks], row_frag(QD, FB, ti2, ks), oa, 0, 0, 0);
                const int tpos = c * 64 + 16 * ti2 + l15;
                if (MODE == 1) {
                    const unsigned ta = (unsigned)tpos;
                    u32x2 o; o.x = cvt_pk_bf16(oa[0], oa[1]); o.y = cvt_pk_bf16(oa[2], oa[3]);
                    *(LAS u32x2*)(OF + ta * 256u + ((((unsigned)(4 * w + g4)) ^ (ta & 31u)) << 3)) = o;
                } else {
                    const unsigned ta = (unsigned)(SCL - 1 - tpos);
                    const u32x2 f = *(const LAS u32x2*)(OF + ta * 256u + ((((unsigned)(4 * w + g4)) ^ (ta & 31u)) << 3));
                    f32x4 ox; ox[0] = oa[0] + bf2f(f.x & 0xffffu); ox[1] = oa[1] + bf2f(f.x >> 16); ox[2] = oa[2] + bf2f(f.y & 0xffffu); ox[3] = oa[3] + bf2f(f.y >> 16);
                    float ss = (ox[0] * ox[0] + ox[1] * ox[1]) + (ox[2] * ox[2] + ox[3] * ox[3]);
                    ss += __shfl_xor(ss, 16); ss += __shfl_xor(ss, 32);
                    if (g4 == 0) RS[(16 * ti2 + l15) * 8 + w] = ss;
                    oxk[ti2] = ox;
                    const int row = scan_row(b, dir, j, tpos);
                    gtk[ti2] = NT_LD((const u32x2*)(P + p_off(20 + h, row) + 16 * w + 4 * g4));
                }
            }
        }
#pragma unroll
        for (int dd = 0; dd < 4; ++dd) {
            const int di = 4 * dh + dd;
            f32x4 tmp0 = (f32x4){0.f, 0.f, 0.f, 0.f}, tmp1 = (f32x4){0.f, 0.f, 0.f, 0.f};
#pragma unroll
            for (int ks = 0; ks < 2; ++ks) { const bf16x8 kf = tr_frag(KD, FB, di, ks);
                tmp0 = __builtin_amdgcn_mfma_f32_16x16x32_bf16(Vt2[0][ks], kf, tmp0, 0, 0, 0); tmp1 = __builtin_amdgcn_mfma_f32_16x16x32_bf16(Vt2[1][ks], kf, tmp1, 0, 0, 0); }
            const int d = 16 * di + l15; const float e63 = VEC[128 + d], e63m = VEC[256 + d];
            st[dd] = st[dd] * e63 + tmp0 * e63m; st[4 + dd] = st[4 + dd] * e63 + tmp1 * e63m;
        }
        __syncthreads();
        if (MODE == 2) {
#pragma unroll
            for (int ti2 = 0; ti2 < 4; ++ti2) {
                const f32x4 ra = *(const LAS f32x4*)(RS + (16 * ti2 + l15) * 8), rb = *(const LAS f32x4*)(RS + (16 * ti2 + l15) * 8 + 4);
                const float tot = ((ra[0] + ra[1]) + (ra[2] + ra[3])) + ((rb[0] + rb[1]) + (rb[2] + rb[3]));
                const float rstd = rsqrtf(tot * (1.0f / HD) + EPS);
                const int row = scan_row(b, dir, j, c * 64 + 16 * ti2 + l15);
                const u32x2 gt = gtk[ti2]; const f32x4 ox = oxk[ti2];
                u32x2 o; o.x = cvt_pk_bf16(ox[0] * rstd * gh[0] * bf2f(gt.x & 0xffffu), ox[1] * rstd * gh[1] * bf2f(gt.x >> 16));
                o.y = cvt_pk_bf16(ox[2] * rstd * gh[2] * bf2f(gt.y & 0xffffu), ox[3] * rstd * gh[3] * bf2f(gt.y >> 16));
                *(u32x2*)(A2 + (size_t)row * DM + 512 + h * 128 + 16 * w + 4 * g4) = o;
            }
        }
    }
#undef HG_LOAD
    if (!OUT) {
#pragma unroll
        for (int k = 0; k < 8; ++k) { const int di = 4 * dh + (k & 3), vt = 2 * vp + (k >> 2); u32x2 u; u.x = cvt_pk_bf16(st[k][0], st[k][1]); u.y = cvt_pk_bf16(st[k][2], st[k][3]); *(u32x2*)(sl + (size_t)(16 * di + l15) * 128 + 16 * vt + 4 * g4) = u; }
        if (w == 0) { float* dl = DL + (size_t)(scan * (NSC + 1) + j) * 128; dl[2 * lane] = ex2(lsum0); dl[2 * lane + 1] = ex2(lsum1); }
    }
}
__device__ __forceinline__ void hgrn_pass1(const Params& p, LAS unsigned char* lds) {
    const int tid = threadIdx.x, lane = tid & 63, w = __builtin_amdgcn_readfirstlane(tid >> 6), G = gridDim.x;
    const int g4 = lane >> 4, l15 = lane & 15;
    const FragBase FB = make_frag_base(lane);
    LAS unsigned char* KD = lds; LAS unsigned char* VV = lds + 65536; LAS float* TOT = (LAS float*)(lds + 131072);
    const bf16_t* P = (const bf16_t*)(p.ws + WS_P);
    bf16_t* SL = (bf16_t*)(p.ws + WS_SL); float* DL = (float*)(p.ws + WS_DL);
    unsigned lfw[32], vw[32];
#define P1_LOAD(it_) do { const int jj_ = (it_) % NSC, scan_ = (it_) / NSC, dir_ = scan_ & 1, bh_ = scan_ >> 1, b_ = bh_ >> 2, h_ = bh_ & 3; const int j_ = (jj_ == NSC - 1) ? NSC : jj_; \
        const int sgn_ = dir_ ? -1 : 1; const int base_ = (j_ < NSC) ? b_ * SEQ + (dir_ ? SEQ - 1 - j_ * SCL : j_ * SCL) : NTOK + b_ * CTXL + (dir_ ? CTXL - 1 : 0); \
        _Pragma("unroll") for (int i = 0; i < 32; ++i) { const int row = base_ + sgn_ * (32 * w + i); \
            lfw[i] = NT_LD((const unsigned*)(P + p_off(12 + dir_ * 4 + h_, row) + 2 * lane)); vw[i] = NT_LD((const unsigned*)(P + p_off(8 + h_, row) + 2 * lane)); } } while (0)
#define P1_ITEM(k_) ((G != 256) ? (((int)blockIdx.x + (k_) * G < 32 * NSC) ? (int)blockIdx.x + (k_) * G : -1) \
        : ((k_) < 3 ? (k_) * 256 + (int)blockIdx.x : ((k_) == 3 ? (((int)blockIdx.x & 3) != 3 ? 768 + ((int)blockIdx.x - ((int)blockIdx.x >> 2)) : -1) : ((k_) == 4 && ((int)blockIdx.x & 3) == 0 ? 960 + ((int)blockIdx.x >> 2) : -1))))
    if (P1_ITEM(0) >= 0) P1_LOAD(P1_ITEM(0));
    for (int k = 0, item = P1_ITEM(0); item >= 0; ++k, item = P1_ITEM(k)) {
        const int jj = item % NSC, scan = item / NSC;
        const int j = (jj == NSC - 1) ? NSC : jj;
        float r0 = 0.f, r1 = 0.f;
#pragma unroll
        for (int i = 0; i < 32; ++i) { r0 += bf2f(lfw[i] & 0xffffu); r1 += bf2f(lfw[i] >> 16); }
        *(LAS f32x2*)(TOT + w * 128 + 2 * lane) = (f32x2){r0, r1};
        __syncthreads();
        float pre0 = 0.f, pre1 = 0.f, bt0 = 0.f, bt1 = 0.f;
#pragma unroll
        for (int ww = 0; ww < 8; ++ww) { const f32x2 tt = *(const LAS f32x2*)(TOT + ww * 128 + 2 * lane); if (ww < w) { pre0 += tt[0]; pre1 += tt[1]; } bt0 += tt[0]; bt1 += tt[1]; }
        float e0 = ex2(fmaxf(bt0 - (pre0 + r0), -115.0f)), e1 = ex2(fmaxf(bt1 - (pre1 + r1), -115.0f));
#pragma unroll
        for (int i = 31; i >= 0; --i) {
            const unsigned t = 32 * w + i; const unsigned a = off_b(t, (unsigned)(lane >> 2)) + 4u * (lane & 3);
            const float f0 = ex2(bf2f(lfw[i] & 0xffffu)), f1 = ex2(bf2f(lfw[i] >> 16));
            const float n0 = f0 * e0, n1 = f1 * e1;
            *(LAS unsigned*)(KD + a) = cvt_pk_bf16(e0 - n0, e1 - n1);
            *(LAS unsigned*)(VV + a) = vw[i];
            e0 = n0; e1 = n1;
        }
        __syncthreads();
        { const int nit = P1_ITEM(k + 1); if (nit >= 0) P1_LOAD(nit); }
        const int vp = w >> 1, dh = w & 1;
        bf16x8 Vt[2][8];
#pragma unroll
        for (int vv = 0; vv < 2; ++vv)
#pragma unroll
            for (int ks = 0; ks < 8; ++ks) Vt[vv][ks] = tr_frag(VV, FB, 2 * vp + vv, ks);
        bf16_t* sl = SL + (size_t)(scan * (NSC + 1) + j) * 16384;
#pragma unroll
        for (int dd = 0; dd < 4; ++dd) {
            const int di = 4 * dh + dd;
            f32x4 acc0 = (f32x4){0.f, 0.f, 0.f, 0.f}, acc1 = (f32x4){0.f, 0.f, 0.f, 0.f};
#pragma unroll
            for (int ks = 0; ks < 8; ++ks) { const bf16x8 kf = tr_frag(KD, FB, di, ks);
                acc0 = __builtin_amdgcn_mfma_f32_16x16x32_bf16(Vt[0][ks], kf, acc0, 0, 0, 0); acc1 = __builtin_amdgcn_mfma_f32_16x16x32_bf16(Vt[1][ks], kf, acc1, 0, 0, 0); }
            u32x2 u0; u0.x = cvt_pk_bf16(acc0[0], acc0[1]); u0.y = cvt_pk_bf16(acc0[2], acc0[3]);
            u32x2 u1; u1.x = cvt_pk_bf16(acc1[0], acc1[1]); u1.y = cvt_pk_bf16(acc1[2], acc1[3]);
            *(u32x2*)(sl + (size_t)(16 * di + l15) * 128 + 16 * (2 * vp) + 4 * g4) = u0;
            *(u32x2*)(sl + (size_t)(16 * di + l15) * 128 + 16 * (2 * vp + 1) + 4 * g4) = u1;
        }
        if (w == 0) { float* dl = DL + (size_t)(scan * (NSC + 1) + j) * 128; dl[2 * lane] = ex2(bt0); dl[2 * lane + 1] = ex2(bt1); }
    }
#undef P1_LOAD
#undef P1_ITEM
}
__device__ __forceinline__ void hgrn_pass3(const Params& p, LAS unsigned char* lds) {
    const int tid = threadIdx.x, lane = tid & 63, w = __builtin_amdgcn_readfirstlane(tid >> 6), G = gridDim.x;
    for (int item = blockIdx.x; item < 16 * NSC; item += G) {
        const int jt = item % NSC, bh = item / NSC, b = bh >> 2, h = bh & 3;
        hgrn_body<1>(p, lds, b, h, 0, jt, lane, w);
        hgrn_body<2>(p, lds, b, h, 1, NSC - 1 - jt, lane, w);
    }
}

__device__ __forceinline__ void hgrn_combine(const Params& p) {
    bf16_t* SL = (bf16_t*)(p.ws + WS_SL); const float* DL = (const float*)(p.ws + WS_DL);
    const size_t gtid = (size_t)blockIdx.x * 512 + threadIdx.x, gsz = (size_t)gridDim.x * 512;
    for (size_t e4 = gtid; e4 < (size_t)32 * 4096; e4 += gsz) {
        const int scan = (int)(e4 >> 12), dv = (int)(e4 & 4095) * 4, d = dv >> 7;
        bf16_t* base = SL + (size_t)scan * (NSC + 1) * 16384 + dv; const float* dl = DL + (size_t)scan * (NSC + 1) * 128 + d;
        u32x2 loc[NSC]; float dec[NSC];
#pragma unroll
        for (int j = 0; j < NSC - 1; ++j) { loc[j] = *(const u32x2*)(base + (size_t)j * 16384); dec[j] = dl[j * 128]; }
        const u32x2 s0 = *(const u32x2*)(base + (size_t)NSC * 16384);
        f32x4 S = (f32x4){bf2f(s0.x & 0xffffu), bf2f(s0.x >> 16), bf2f(s0.y & 0xffffu), bf2f(s0.y >> 16)};
#pragma unroll
        for (int j = 0; j < NSC; ++j) {
            u32x2 o; o.x = cvt_pk_bf16(S[0], S[1]); o.y = cvt_pk_bf16(S[2], S[3]); *(u32x2*)(base + (size_t)j * 16384) = o;
            if (j < NSC - 1) { const f32x4 L = (f32x4){bf2f(loc[j].x & 0xffffu), bf2f(loc[j].x >> 16), bf2f(loc[j].y & 0xffffu), bf2f(loc[j].y >> 16)}; S = S * dec[j] + L; }
        }
    }
}

__device__ __forceinline__ void phase_mix(const Params& p, LAS unsigned char* lds) {
    const int tid = threadIdx.x, lane = tid & 63, wave = tid >> 6, G = gridDim.x;
    const bf16_t* P = (const bf16_t*)(p.ws + WS_P); bf16_t* A2 = (bf16_t*)(p.ws + WS_A2);
    const bf16_t* WpT = (const bf16_t*)(p.ws + WS_WPT);
    LAS float* vs = (LAS float*)lds;
    LAS bf16_t* dA = (LAS bf16_t*)(lds + 2 * 64 * 132 * 4);
    const int mt = wave >> 1, nh = wave & 1, fr = lane & 15, fq = lane >> 4;
    for (int item = blockIdx.x; item < NB * 4 * 16; item += G) {
        const int g = item & 3, rb = (item >> 2) & 15, b = item >> 6;
        const int w = 2 << g, hw = w >> 1;
        bf16x8 bfr[4][4];
#pragma unroll
        for (int kk = 0; kk < 4; ++kk)
#pragma unroll
            for (int nf = 0; nf < 4; ++nf) bfr[kk][nf] = *(const bf16x8*)(WpT + (size_t)g * 16384 + (size_t)(64 * nh + nf * 16 + fr) * 128 + kk * 32 + fq * 8);
        const bf16_t* Pg = P + p_off(g, b * SEQ);
        float vsum[4][8];
        const int rfirst = rb * 8;
#pragma unroll
        for (int i = 0; i < 4; ++i)
#pragma unroll
            for (int k = 0; k < 8; ++k) vsum[i][k] = 0.f;
#pragma unroll
        for (int st = 0; st < 2; ++st) {
            const int r0 = rfirst + 4 * st;
#pragma unroll 1
            for (int cb = 0; cb < 2 * hw; cb += 4) {
                u32x4 uu[2][4];
#pragma unroll
                for (int hf = 0; hf < 2; ++hf) {
                    const int q = tid + 512 * hf, cc = q >> 4, ch = q & 15;
#pragma unroll
                    for (int d = 0; d < 4; ++d) { const int rr = r0 - hw + cb + d; const bool ok = rr >= 0 && rr < 128 && (cb + d) < 2 * hw;
                        uu[hf][d] = ok ? *(const u32x4*)(Pg + (size_t)(rr * 64 + cc) * 128 + ch * 8) : (u32x4){0u, 0u, 0u, 0u}; }
                }
#pragma unroll
                for (int hf = 0; hf < 2; ++hf)
#pragma unroll
                    for (int d = 0; d < 4; ++d) { const u32x4 u = uu[hf][d]; const int i = st * 2 + hf;
                        vsum[i][0] += bf2f(u.x & 0xffffu); vsum[i][1] += bf2f(u.x >> 16); vsum[i][2] += bf2f(u.y & 0xffffu); vsum[i][3] += bf2f(u.y >> 16);
                        vsum[i][4] += bf2f(u.z & 0xffffu); vsum[i][5] += bf2f(u.z >> 16); vsum[i][6] += bf2f(u.w & 0xffffu); vsum[i][7] += bf2f(u.w >> 16); }
            }
        }
#pragma unroll 1
        for (int s4 = 0; s4 < 4; ++s4) {
            u32x4 cen[4], addv[4], subv[4];
#pragma unroll
            for (int i = 0; i < 4; ++i) {
                const int st = i >> 1, q = tid + 512 * (i & 1), cc = q >> 4, ch = q & 15, r = rfirst + 4 * st + s4;
                const bool hasadd = (r + hw) < 128, hassub = (r - hw) >= 0;
                cen[i] = *(const u32x4*)(Pg + (size_t)(r * 64 + cc) * 128 + ch * 8);
                addv[i] = hasadd ? *(const u32x4*)(Pg + (size_t)((r + hw) * 64 + cc) * 128 + ch * 8) : (u32x4){0u, 0u, 0u, 0u};
                subv[i] = hassub ? *(const u32x4*)(Pg + (size_t)((r - hw) * 64 + cc) * 128 + ch * 8) : (u32x4){0u, 0u, 0u, 0u};
#pragma unroll
                for (int k = 0; k < 8; ++k) vs[(st * 64 + cc) * 132 + ch * 8 + k] = vsum[i][k];
            }
            __syncthreads();
#pragma unroll
            for (int i = 0; i < 4; ++i) {
                const int st = i >> 1, q = tid + 512 * (i & 1), cc = q >> 4, ch = q & 15, r = rfirst + 4 * st + s4;
                const int nr = min(r + hw, 128) - max(r - hw, 0);
                const int c0 = max(cc - hw, 0), c1 = min(cc + hw, 64);
                float a[8];
#pragma unroll
                for (int k = 0; k < 8; ++k) a[k] = 0.f;
                for (int c2 = c0; c2 < c1; ++c2) {
#pragma unroll
                    for (int k = 0; k < 8; ++k) a[k] += vs[(st * 64 + c2) * 132 + ch * 8 + k];
                }
                const float inv = __builtin_amdgcn_rcpf((float)(nr * (c1 - c0)));
                const u32x4 u = cen[i];
                u32x4 o; o.x = cvt_pk_bf16(a[0] * inv - bf2f(u.x & 0xffffu), a[1] * inv - bf2f(u.x >> 16)); o.y = cvt_pk_bf16(a[2] * inv - bf2f(u.y & 0xffffu), a[3] * inv - bf2f(u.y >> 16));
                o.z = cvt_pk_bf16(a[4] * inv - bf2f(u.z & 0xffffu), a[5] * inv - bf2f(u.z >> 16)); o.w = cvt_pk_bf16(a[6] * inv - bf2f(u.w & 0xffffu), a[7] * inv - bf2f(u.w >> 16));
                *(LAS u32x4*)(dA + (st * 64 + cc) * 136 + ch * 8) = o;
                const u32x4 pa = addv[i], ps = subv[i];
                vsum[i][0] += bf2f(pa.x & 0xffffu) - bf2f(ps.x & 0xffffu); vsum[i][1] += bf2f(pa.x >> 16) - bf2f(ps.x >> 16);
                vsum[i][2] += bf2f(pa.y & 0xffffu) - bf2f(ps.y & 0xffffu); vsum[i][3] += bf2f(pa.y >> 16) - bf2f(ps.y >> 16);
                vsum[i][4] += bf2f(pa.z & 0xffffu) - bf2f(ps.z & 0xffffu); vsum[i][5] += bf2f(pa.z >> 16) - bf2f(ps.z >> 16);
                vsum[i][6] += bf2f(pa.w & 0xffffu) - bf2f(ps.w & 0xffffu); vsum[i][7] += bf2f(pa.w >> 16) - bf2f(ps.w >> 16);
            }
            __syncthreads();
#pragma unroll
            for (int st = 0; st < 2; ++st) {
                f32x4 acc[4];
#pragma unroll
                for (int nf = 0; nf < 4; ++nf) acc[nf] = (f32x4){0.f, 0.f, 0.f, 0.f};
#pragma unroll
                for (int kk = 0; kk < 4; ++kk) {
                    const bf16x8 af = *(const LAS bf16x8*)(dA + (st * 64 + 16 * mt + fr) * 136 + kk * 32 + fq * 8);
#pragma unroll
                    for (int nf = 0; nf < 4; ++nf) acc[nf] = __builtin_amdgcn_mfma_f32_16x16x32_bf16(bfr[kk][nf], af, acc[nf], 0, 0, 0);
                }
                const int r = rfirst + 4 * st + s4;
#pragma unroll
                for (int nf = 0; nf < 4; ++nf) {
                    u32x2 o; o.x = cvt_pk_bf16(acc[nf][0], acc[nf][1]); o.y = cvt_pk_bf16(acc[nf][2], acc[nf][3]);
                    *(u32x2*)(A2 + (size_t)(b * SEQ + r * 64 + 16 * mt + fr) * DM + g * 128 + 64 * nh + nf * 16 + 4 * fq) = o;
                }
            }
        }
        __syncthreads();
    }
}

constexpr int CNT_STRIDE = 16;
__device__ __forceinline__ float tr_reduce8(const float (&v)[8], int lane) {
    float r4[4], r2[2], r1;
    const bool h5 = (lane & 32) != 0, h4 = (lane & 16) != 0, h3 = (lane & 8) != 0;
#pragma unroll
    for (int i = 0; i < 4; ++i) { const float keep = h5 ? v[4 + i] : v[i], send = h5 ? v[i] : v[4 + i]; r4[i] = keep + __shfl_xor(send, 32); }
#pragma unroll
    for (int i = 0; i < 2; ++i) { const float keep = h4 ? r4[2 + i] : r4[i], send = h4 ? r4[i] : r4[2 + i]; r2[i] = keep + __shfl_xor(send, 16); }
    { const float keep = h3 ? r2[1] : r2[0], send = h3 ? r2[0] : r2[1]; r1 = keep + __shfl_xor(send, 8); }
    r1 += __shfl_xor(r1, 4); r1 += __shfl_xor(r1, 2); r1 += __shfl_xor(r1, 1);
    return r1;
}
__device__ __forceinline__ void phase_route(const Params& p, LAS unsigned char* lds) {
    const int tid = threadIdx.x, lane = tid & 63, wave = tid >> 6, G = gridDim.x;
    const float* mod = (const float*)(p.ws + WS_MOD);
    bf16_t* H2 = (bf16_t*)(p.ws + WS_H2); int* inv = (int*)(p.ws + WS_INV); int* cnt = (int*)(p.ws + WS_CTL);
    bf16_t* X1 = (bf16_t*)(p.ws + WS_X1);
    LAS f32x4* WR = (LAS f32x4*)lds;
    LAS int* hist = (LAS int*)(lds + LDS_TAB); LAS int* basee = hist + 32;
    { f32x4 t[16];
#pragma unroll
      for (int i = 0; i < 16; ++i) t[i] = *(const f32x4*)(p.w_router + (size_t)(tid + 512 * i) * 4);
#pragma unroll
      for (int i = 0; i < 16; ++i) {
        const int f = tid + 512 * i;
        const int half = f & 1, k = (f >> 1) & 1023, g = f >> 11;
        const int j = k >> 8, ln = (k & 255) >> 2, q = k & 3;
        WR[(((g * 4 + j) * 4 + q) * 2 + half) * 64 + ln] = t[i];
      } }
    float wg[4][4][4];
#pragma unroll
    for (int j = 0; j < 4; ++j)
#pragma unroll
        for (int q = 0; q < 4; ++q) { const f32x4 t = *(const f32x4*)(p.w_group + (size_t)(256 * j + 4 * lane + q) * 4); wg[j][q][0] = t[0]; wg[j][q][1] = t[1]; wg[j][q][2] = t[2]; wg[j][q][3] = t[3]; }
    constexpr int TPB = 128;
    for (int blk = blockIdx.x; blk < NTOK / TPB; blk += G) {
        if (tid < 32) hist[tid] = 0;
        LAS float* lgf = (LAS float*)(lds + LDS_GEMM); LAS float* lsh = lgf + 1024; LAS float* lsc = lsh + 1024; LAS float* lbg = lsc + 1024; LAS float* lbr = lbg + 4;
        { const int bb = (blk * TPB) / SEQ;
          for (int i = tid; i < 1024; i += 512) { lgf[i] = p.g_ffn[i]; lsh[i] = mod[bb * 6144 + 3072 + i]; lsc[i] = 1.0f + mod[bb * 6144 + 4096 + i]; }
          if (tid < 4) lbg[tid] = p.b_group[tid];
          if (tid < 32) lbr[tid] = p.b_router[tid]; }
        __syncthreads();
        LAS int* asg = (LAS int*)(lds + LDS_TAB + 1024) + wave * 64;
        f32x4 nx[2][4]; u32x2 ny[2][4];
        { const int tok0 = blk * TPB + wave * 16;
#pragma unroll
          for (int u = 0; u < 2; ++u)
#pragma unroll
            for (int j = 0; j < 4; ++j) { nx[u][j] = NT_LD((const f32x4*)(p.x + (size_t)(tok0 + u) * DM + 4 * lane + 256 * j)); ny[u][j] = *(const u32x2*)(X1 + (size_t)(tok0 + u) * DM + 4 * lane + 256 * j); } }
#pragma unroll 1
        for (int it = 0; it < 16; it += 2) {
            const int tok = blk * TPB + wave * 16 + it;
            const int b = tok / SEQ;
            f32x4 v[2][4]; u32x2 yv[2][4]; float s[2] = {0.f, 0.f};
#pragma unroll
            for (int u = 0; u < 2; ++u)
#pragma unroll
                for (int j = 0; j < 4; ++j) { v[u][j] = nx[u][j]; yv[u][j] = ny[u][j]; }
            if (it < 14) {
#pragma unroll
                for (int u = 0; u < 2; ++u)
#pragma unroll
                    for (int j = 0; j < 4; ++j) { nx[u][j] = NT_LD((const f32x4*)(p.x + (size_t)(tok + 2 + u) * DM + 4 * lane + 256 * j)); ny[u][j] = *(const u32x2*)(X1 + (size_t)(tok + 2 + u) * DM + 4 * lane + 256 * j); }
            }
#pragma unroll
            for (int u = 0; u < 2; ++u) {
                bf16_t* x1r = X1 + (size_t)(tok + u) * DM;
#pragma unroll
                for (int j = 0; j < 4; ++j) { const u32x2 y = yv[u][j];
                    v[u][j][0] += bf2f(y.x & 0xffffu); v[u][j][1] += bf2f(y.x >> 16); v[u][j][2] += bf2f(y.y & 0xffffu); v[u][j][3] += bf2f(y.y >> 16);
                    u32x2 w; w.x = cvt_pk_bf16(v[u][j][0], v[u][j][1]); w.y = cvt_pk_bf16(v[u][j][2], v[u][j][3]); *(u32x2*)(x1r + 4 * lane + 256 * j) = w;
                    s[u] += (v[u][j][0] * v[u][j][0] + v[u][j][1] * v[u][j][1]) + (v[u][j][2] * v[u][j][2] + v[u][j][3] * v[u][j][3]); }
            }
#pragma unroll
            for (int o = 1; o < 64; o <<= 1) { const float t0 = __shfl_xor(s[0], o), t1 = __shfl_xor(s[1], o); s[0] += t0; s[1] += t1; }
            float rstd[2];
#pragma unroll
            for (int u = 0; u < 2; ++u) rstd[u] = rsqrtf(s[u] * (1.0f / DM) + EPS);
            float gl8[2][8];
#pragma unroll
            for (int u = 0; u < 2; ++u)
#pragma unroll
                for (int e = 0; e < 8; ++e) gl8[u][e] = 0.f;
#pragma unroll
            for (int j = 0; j < 4; ++j) {
                const int col = 4 * lane + 256 * j;
                const f32x4 g = *(const LAS f32x4*)(lgf + col), sh = *(const LAS f32x4*)(lsh + col), scl = *(const LAS f32x4*)(lsc + col);
#pragma unroll
                for (int u = 0; u < 2; ++u) {
#pragma unroll
                    for (int q = 0; q < 4; ++q) { v[u][j][q] = v[u][j][q] * rstd[u] * g[q] * scl[q] + sh[q];
                        gl8[u][0] += v[u][j][q] * wg[j][q][0]; gl8[u][1] += v[u][j][q] * wg[j][q][1]; gl8[u][2] += v[u][j][q] * wg[j][q][2]; gl8[u][3] += v[u][j][q] * wg[j][q][3]; }
                    *(unsigned*)((unsigned char*)H2 + (size_t)(tok + u) * DM + col) = pk4_fp8(v[u][j][0], v[u][j][1], v[u][j][2], v[u][j][3]);
                }
            }
            float gr[2];
            gr[0] = tr_reduce8(gl8[0], lane); gr[1] = tr_reduce8(gl8[1], lane);
            int gs[2]; float pgrp[2];
#pragma unroll
            for (int u = 0; u < 2; ++u) {
                float gl[4];
#pragma unroll
                for (int q = 0; q < 4; ++q) gl[q] = __int_as_float(__builtin_amdgcn_readlane(__float_as_int(gr[u]), 8 * q)) + lbg[q];
                int gsel = 0; float gm = gl[0];
#pragma unroll
                for (int q = 1; q < 4; ++q) if (gl[q] > gm) { gm = gl[q]; gsel = q; }
                float den = 0.f;
#pragma unroll
                for (int q = 0; q < 4; ++q) den += expf(gl[q] - gm);
                pgrp[u] = 1.0f / den; gs[u] = gsel;
            }
            float rl8[2][8];
#pragma unroll
            for (int u = 0; u < 2; ++u) {
#pragma unroll
                for (int e = 0; e < 8; ++e) rl8[u][e] = 0.f;
#pragma unroll
                for (int j = 0; j < 4; ++j)
#pragma unroll
                    for (int q = 0; q < 4; ++q) {
                        const f32x4 w0 = WR[(((gs[u] * 4 + j) * 4 + q) * 2 + 0) * 64 + lane], w1 = WR[(((gs[u] * 4 + j) * 4 + q) * 2 + 1) * 64 + lane];
#pragma unroll
                        for (int e = 0; e < 4; ++e) { rl8[u][e] += v[u][j][q] * w0[e]; rl8[u][4 + e] += v[u][j][q] * w1[e]; }
                    }
            }
            float rr[2];
            rr[0] = tr_reduce8(rl8[0], lane); rr[1] = tr_reduce8(rl8[1], lane);
#pragma unroll
            for (int u = 0; u < 2; ++u) {
                float rl[8];
#pragma unroll
                for (int e = 0; e < 8; ++e) rl[e] = __int_as_float(__builtin_amdgcn_readlane(__float_as_int(rr[u]), 8 * e)) + lbr[gs[u] * 8 + e];
                int i1 = 0; float m1 = rl[0];
#pragma unroll
                for (int e = 1; e < 8; ++e) if (rl[e] > m1) { m1 = rl[e]; i1 = e; }
                int i2 = (i1 == 0) ? 1 : 0; float m2 = -3.0e38f;
#pragma unroll
                for (int e = 0; e < 8; ++e) if (e != i1 && rl[e] > m2) { m2 = rl[e]; i2 = e; }
                const float p1 = 1.0f / (1.0f + expf(m2 - m1)), p2 = 1.0f - p1;
                if (lane < 2) {
                    const int eid = gs[u] * 8 + (lane == 0 ? i1 : i2);
                    const int rk = __hip_atomic_fetch_add(hist + eid, 1, __ATOMIC_RELAXED, __HIP_MEMORY_SCOPE_WORKGROUP);
                    asg[(it + u) * 2 + lane] = eid | (rk << 8); asg[32 + (it + u) * 2 + lane] = __float_as_int(pgrp[u] * (lane == 0 ? p1 : p2));
                }
            }
        }
        __syncthreads();
        if (tid < 32) basee[tid] = atomicAdd(cnt + tid * CNT_STRIDE, hist[tid]);
        __syncthreads();
        if (lane < 32) {
            const int a = asg[lane], e = a & 255, rk = a >> 8; const int tok = blk * TPB + wave * 16 + (lane >> 1); const int pos = basee[e] + rk;
            if (pos >= 0 && pos < NTOK) inv[(size_t)e * NTOK + pos] = (int)((unsigned)(tok * 2 + (lane & 1)) | (cvt_pk_bf16(__int_as_float(asg[32 + lane]), 0.f) << 16));
        }
        __syncthreads();
    }
}
__device__ __forceinline__ void moe_table(const Params& p, LAS unsigned char* lds) {
    LAS int* tab = (LAS int*)(lds + LDS_TAB);
    const int* cnt = (const int*)(p.ws + WS_CTL);
    const int tid = threadIdx.x;
    __syncthreads();
    if (tid < 64) {
        int c = 0; if (tid < 32) { c = __hip_atomic_load(cnt + tid * CNT_STRIDE, __ATOMIC_RELAXED, __HIP_MEMORY_SCOPE_AGENT); tab[64 + tid] = c; }
        const int n = (c + 255) >> 8; int s = n;
#pragma unroll
        for (int o = 1; o < 64; o <<= 1) { const int t = __shfl_up(s, o); if (tid >= o) s += t; }
        if (tid <= 32) tab[tid] = s - n;
    }
    __syncthreads();
    for (int mt = tid; mt < MAXMT; mt += 512) { int e = 0;
#pragma unroll
        for (int k = 1; k < 32; ++k) e += (tab[k] <= mt) ? 1 : 0;
        ((LAS unsigned char*)tab)[384 + mt] = (unsigned char)e; }
    __syncthreads();
}
__device__ __forceinline__ void phase_final(const Params& p) {
    const int tid = threadIdx.x, lane = tid & 63, wave = tid >> 6, G = gridDim.x;
    const int gw = blockIdx.x * 8 + wave, NW = G * 8;
    const float* mod = (const float*)(p.ws + WS_MOD); const unsigned char* Y = (const unsigned char*)(p.ws + WS_Y); const bf16_t* X1 = (const bf16_t*)(p.ws + WS_X1);
    constexpr int NT = 2;
    for (int t0 = gw * NT; t0 < NTOK; t0 += NW * NT) {
        const int b = t0 / SEQ;
        u32x4 xx[NT][2]; u32x2 ya[NT][2], yb[NT][2];
#pragma unroll
        for (int u = 0; u < NT; ++u)
#pragma unroll
            for (int j = 0; j < 2; ++j) { const int col = 8 * lane + 512 * j; const size_t tok = t0 + u;
                xx[u][j] = NT_LD((const u32x4*)(X1 + tok * DM + col)); ya[u][j] = NT_LD((const u32x2*)(Y + (2 * tok) * DM + col)); yb[u][j] = NT_LD((const u32x2*)(Y + (2 * tok + 1) * DM + col)); }
        f32x4 ga[2][2], gf[2][2];
#pragma unroll
        for (int j = 0; j < 2; ++j) { const int col = 8 * lane + 512 * j;
            ga[j][0] = *(const f32x4*)(mod + b * 6144 + 5120 + col) * Y8_INV; ga[j][1] = *(const f32x4*)(mod + b * 6144 + 5120 + col + 4) * Y8_INV;
            gf[j][0] = *(const f32x4*)(p.g_final + col); gf[j][1] = *(const f32x4*)(p.g_final + col + 4); }
#pragma unroll
        for (int u = 0; u < NT; ++u) {
            f32x4 v[2][2]; float s = 0.f;
#pragma unroll
            for (int j = 0; j < 2; ++j) {
                const u32x4 X = xx[u][j]; const u32x2 A = ya[u][j], B = yb[u][j];
                const f32x2 a0 = __builtin_amdgcn_cvt_pk_f32_fp8((int)A.x, false) + __builtin_amdgcn_cvt_pk_f32_fp8((int)B.x, false), a1 = __builtin_amdgcn_cvt_pk_f32_fp8((int)A.x, true) + __builtin_amdgcn_cvt_pk_f32_fp8((int)B.x, true);
                const f32x2 a2 = __builtin_amdgcn_cvt_pk_f32_fp8((int)A.y, false) + __builtin_amdgcn_cvt_pk_f32_fp8((int)B.y, false), a3 = __builtin_amdgcn_cvt_pk_f32_fp8((int)A.y, true) + __builtin_amdgcn_cvt_pk_f32_fp8((int)B.y, true);
                v[j][0][0] = bf2f(X.x & 0xffffu) + ga[j][0][0] * a0[0]; v[j][0][1] = bf2f(X.x >> 16) + ga[j][0][1] * a0[1];
                v[j][0][2] = bf2f(X.y & 0xffffu) + ga[j][0][2] * a1[0]; v[j][0][3] = bf2f(X.y >> 16) + ga[j][0][3] * a1[1];
                v[j][1][0] = bf2f(X.z & 0xffffu) + ga[j][1][0] * a2[0]; v[j][1][1] = bf2f(X.z >> 16) + ga[j][1][1] * a2[1];
                v[j][1][2] = bf2f(X.w & 0xffffu) + ga[j][1][2] * a3[0]; v[j][1][3] = bf2f(X.w >> 16) + ga[j][1][3] * a3[1];
#pragma unroll
                for (int h = 0; h < 2; ++h) s += (v[j][h][0] * v[j][h][0] + v[j][h][1] * v[j][h][1]) + (v[j][h][2] * v[j][h][2] + v[j][h][3] * v[j][h][3]);
            }
            const float rstd = rsqrtf(wave_sum(s) * (1.0f / DM) + EPS);
            float* orow = p.out + (size_t)(t0 + u) * DM;
#pragma unroll
            for (int j = 0; j < 2; ++j)
#pragma unroll
                for (int h = 0; h < 2; ++h) NT_ST(v[j][h] * rstd * gf[j][h], (f32x4*)(orow + 8 * lane + 512 * j + 4 * h));
        }
    }
}

#define XB_TMO      128
#define XB_XCNT(j)  (256  + 64 * (j))
#define XB_XSUB(j)  (1280 + 64 * (j))
#define XB_XGEN(j)  (2304 + 64 * (j))
#define XB_TOP      3328
#define XB_TOPGEN   3392
#define XCD_BAR_WORDS 3456
#define XB_SPIN_CAP (1u << 18)
__device__ __forceinline__ unsigned xb_ld(unsigned* p)              { return __hip_atomic_load(p, __ATOMIC_RELAXED, __HIP_MEMORY_SCOPE_AGENT); }
__device__ __forceinline__ unsigned xb_add(unsigned* p, unsigned v) { return __hip_atomic_fetch_add(p, v, __ATOMIC_RELAXED, __HIP_MEMORY_SCOPE_AGENT); }
__device__ __forceinline__ unsigned xb_xcc_id() { return (unsigned)__builtin_amdgcn_s_getreg((3 << 11) | 20) & 0xFu; }
#define XB_SPIN(cond, bar) do { unsigned _sp = 0; while (cond) { __builtin_amdgcn_s_sleep(1); \
    if ((++_sp & 255u) == 0u) { if (xb_ld(&(bar)[XB_TMO])) break; if (_sp > XB_SPIN_CAP) { atomicAdd(&(bar)[XB_TMO], 1u); break; } } } } while (0)
struct XcdBarrier { unsigned* bar; unsigned x; volatile LAS unsigned* st; };
__device__ __forceinline__ XcdBarrier xcd_barrier_post(unsigned* bar, volatile LAS unsigned* st) {
    XcdBarrier b; b.bar = bar; b.x = xb_xcc_id(); b.st = st;
    if (threadIdx.x == 0) (void)xb_add(&bar[XB_XCNT(b.x)], 1u);
    return b;
}
__device__ __forceinline__ void xcd_barrier_complete(unsigned* bar, unsigned x, unsigned& nloc, unsigned& nx) {
    const unsigned G = gridDim.x * gridDim.y * gridDim.z;
    unsigned sum, cnt, mine, sp = 0u;
    for (;;) {
        sum = 0u; cnt = 0u; mine = 0u;
#pragma unroll
        for (unsigned j = 0; j < 16; ++j) { const unsigned c = xb_ld(&bar[XB_XCNT(j)]); sum += c; cnt += (c > 0u) ? 1u : 0u; mine = (j == x) ? c : mine; }
        if (sum == G) break;
        __builtin_amdgcn_s_sleep(1);
        if ((++sp & 255u) == 0u) { if (xb_ld(&bar[XB_TMO])) break; if (sp > XB_SPIN_CAP) { atomicAdd(&bar[XB_TMO], 1u); break; } }
    }
    nloc = mine > 0u ? mine : 1u; nx = cnt > 0u ? cnt : 1u;
}
__device__ __forceinline__ void xcd_barrier(const XcdBarrier& b) {
    asm volatile("s_waitcnt vmcnt(0)" ::: "memory");
    __syncthreads();
    if (threadIdx.x == 0) {
        unsigned* bar = b.bar;
        __builtin_amdgcn_s_waitcnt(0);
        unsigned nloc = b.st[0], nx = b.st[1];
        if (nloc == 0u) { xcd_barrier_complete(bar, b.x, nloc, nx); b.st[0] = nloc; b.st[1] = nx; }
        const unsigned old = xb_add(&bar[XB_XSUB(b.x)], 1u);
        const unsigned gen = old / nloc;
        if (old + 1u == (gen + 1u) * nloc) {
            __builtin_amdgcn_fence(__ATOMIC_RELEASE, "agent");
            asm volatile("s_waitcnt vmcnt(0)" ::: "memory");
            const unsigned og = xb_add(&bar[XB_TOP], 1u);
            const unsigned tg = og / nx;
            if (og + 1u == (tg + 1u) * nx) xb_add(&bar[XB_TOPGEN], 1u);
            else XB_SPIN(xb_ld(&bar[XB_TOPGEN]) == tg, bar);
            __builtin_amdgcn_fence(__ATOMIC_ACQUIRE, "agent");
            xb_add(&bar[XB_XGEN(b.x)], 1u);
            asm volatile("s_waitcnt vmcnt(0)" ::: "memory");
        } else {
            XB_SPIN(xb_ld(&bar[XB_XGEN(b.x)]) == gen, bar);
            __builtin_amdgcn_fence(__ATOMIC_ACQUIRE, "agent");
            asm volatile("s_waitcnt vmcnt(0)" ::: "memory");
        }
    }
    __syncthreads();
}

#define RUN_PHASE(n, ...) if ((p.phases >> (n)) & 1u) { if ((n) > 0) xcd_barrier(xb); __VA_ARGS__; }
__global__ void __launch_bounds__(512, 2) fwd_kernel(Params p) {
    extern __shared__ __attribute__((aligned(16))) unsigned char shm[];
    LAS unsigned char* lds = (LAS unsigned char*)shm;
    cg::grid_group grid = cg::this_grid();
    const int G = gridDim.x, c = blockIdx.x;
    volatile LAS unsigned* xst = (volatile LAS unsigned*)(lds + LDS_TAB + 1008);
    if (threadIdx.x == 0) { xst[0] = 0u; xst[1] = 0u; }
    __syncthreads();
    XcdBarrier xb; xb.bar = (unsigned*)(p.ws + WS_BAR); xb.x = 0u; xb.st = xst;
    xb = xcd_barrier_post((unsigned*)(p.ws + WS_BAR), xst);
    if (p.ws == nullptr) grid.sync();
    RUN_PHASE(0, phase0(p, lds);)
    RUN_PHASE(1, phase1(p, lds);)
    RUN_PHASE(2, { SchedDenseT<true> S; S.A = (const char*)(p.ws + WS_HX); S.Bt = (const char*)(p.ws + WS_WINT8); S.K = DM / 2; S.nM = NTOK / 256; S.nN = DIN / 256; S.G = G; S.c = c; S.nextra = (G > 48) ? 0 : 24; S.ex_pm0 = NTOK / 256; S.ex_pn0 = 4; S.ex_nn = 6;
                  EpiPT<true> E; E.P = (bf16_t*)(p.ws + WS_P); E.lbl = p.lb_logits; E.sa = (const float*)(p.ws + WS_SA); E.cmax = (const float*)(p.ws + WS_CMAX);
                  { LAS float* lcm = (LAS float*)(lds + LDS_GEMM); LAS float* llb = lcm + DIN;
                    { float t[6], l0[2], l1[2];
                      _Pragma("unroll") for (int q = 0; q < 6; ++q) t[q] = E.cmax[threadIdx.x + 512 * q];
                      _Pragma("unroll") for (int q = 0; q < 2; ++q) { const int i = threadIdx.x + 512 * q, dir = i >> 9, cc = i & 511; l0[q] = p.lb_logits[dir * 1024 + cc]; l1[q] = p.lb_logits[dir * 1024 + 512 + cc]; }
                      _Pragma("unroll") for (int q = 0; q < 6; ++q) lcm[threadIdx.x + 512 * q] = t[q];
                      _Pragma("unroll") for (int q = 0; q < 2; ++q) llb[threadIdx.x + 512 * q] = sigmoid_f(l0[q] - l1[q]); }
                    E.lcm = lcm; E.llb = llb; E.lrs = llb + 1024; __syncthreads(); }
                  pg8::gemm_phase(lds, DM / 2, S, E); })
    RUN_PHASE(3, { hgrn_pass1(p, lds); __syncthreads(); phase_mix(p, lds); })
    RUN_PHASE(4, hgrn_combine(p);)
    RUN_PHASE(5, hgrn_pass3(p, lds);)
    RUN_PHASE(7, { SchedDenseT<false> S; S.A = (const char*)(p.ws + WS_A2); S.Bt = (const char*)(p.ws + WS_WOUTT); S.K = DM; S.nM = NTOK / 256; S.nN = DM / 256; S.G = G; S.c = c; S.nextra = 0; S.ex_pm0 = 0; S.ex_pn0 = 0; S.ex_nn = 1;
                  EpiX1 E; E.out = (bf16_t*)(p.ws + WS_X1);
                  { LAS float* lga = (LAS float*)(lds + LDS_GEMM); const float* mod = (const float*)(p.ws + WS_MOD);
                    { float t[8];
                      _Pragma("unroll") for (int q = 0; q < 8; ++q) { const int i = threadIdx.x + 512 * q; t[q] = mod[(i >> 10) * 6144 + 2048 + (i & 1023)]; }
                      _Pragma("unroll") for (int q = 0; q < 8; ++q) lga[threadIdx.x + 512 * q] = t[q]; }
                    E.lga = lga; __syncthreads(); }
                  pg8::gemm_phase(lds, DM, S, E); })
    RUN_PHASE(8, phase_route(p, lds);)
#define MOE_SCHED_A(S_) SchedMoE<true> S_; S_.A = (const char*)(p.ws + WS_H2); S_.W = (const char*)(p.ws + WS_W13T); S_.wstride = (size_t)1024 * 1024; S_.K = DM / 2; S_.G = G; S_.c = c; S_.tab = (LAS const int*)(lds + LDS_TAB); S_.inv = (const int*)(p.ws + WS_INV); S_.l_first = 0; S_.l_count = 0; S_.l_stride = 1
#define MOE_SCHED_B(S_) SchedMoE<false> S_; S_.A = (const char*)(p.ws + WS_HH); S_.W = (const char*)(p.ws + WS_W2T); S_.wstride = (size_t)1024 * 512; S_.K = DE / 2; S_.G = G; S_.c = c; S_.tab = (LAS const int*)(lds + LDS_TAB); S_.inv = (const int*)(p.ws + WS_INV); S_.i_lo = 0; S_.i_hi = -1
#define MOE_EPI_Y(E_) EpiY E_; E_.Y = (unsigned char*)(p.ws + WS_Y); E_.inv = (const int*)(p.ws + WS_INV); E_.tab = (LAS const int*)(lds + LDS_TAB); E_.lpe = (LAS unsigned*)(lds + LDS_GEMM)
#define MOE_GEOM const int total = ((LAS const int*)(lds + LDS_TAB))[32]; const int MPR = G >> 2; const int FR = total / MPR, R = total - FR * MPR; const int mc = (c & 7) * (G >> 5) + (c >> 5), pnc = (c >> 3) & 3; \
                 const bool tail = mc < R; const int qo = FR, qt = FR >= 2 ? FR - 2 : 0; const int NY = (G - 4 * R) * qo + 4 * R * qt
    RUN_PHASE(9, { moe_table(p, lds); MOE_GEOM; (void)tail; (void)NY; (void)pnc; MOE_SCHED_A(S); S.i_lo = 0; S.i_hi = FR;
                  EpiH E; E.H = (bf16_t*)(p.ws + WS_HH); pg8::gemm_phase(lds, DM / 2, S, E); })
    RUN_PHASE(10, {   MOE_GEOM;
                  if (tail) { MOE_SCHED_A(S); S.i_lo = FR; S.i_hi = FR + 1; EpiH E; E.H = (bf16_t*)(p.ws + WS_HH); pg8::gemm_phase(lds, DM / 2, S, E); __syncthreads(); }
                  { MOE_SCHED_B(S); if (tail) { S.l_first = (G - 4 * R) * qo + (mc * 4 + pnc) * qt; S.l_count = qt; } else { S.l_first = ((mc - R) * 4 + pnc) * qo; S.l_count = qo; } S.l_stride = 1;
                    MOE_EPI_Y(E); pg8::gemm_phase(lds, DE / 2, S, E); } })
    RUN_PHASE(11, { MOE_GEOM; (void)tail; (void)mc; (void)pnc; MOE_SCHED_B(S); S.l_first = NY + c; S.l_stride = G; S.l_count = (total * 4 - NY - c + G - 1) / G;
                  MOE_EPI_Y(E); pg8::gemm_phase(lds, DE / 2, S, E); })
    RUN_PHASE(12, phase_final(p);)
}

extern "C" void kernel_launch(void* const* d_in, const int* in_sizes, int n_in, void* d_out, int out_size, void* d_ws, size_t ws_size, hipStream_t stream) {
    static int grid_blocks = 0;
    if (grid_blocks == 0) {
        if (n_in != 22 || in_sizes[0] != NTOK * DM || out_size != NTOK * DM || ws_size < WS_END) {
            fprintf(stderr, "kernel_launch: unexpected shapes: n_in %d in0 %d out %d ws %zu (need %zu)\n", n_in, n_in > 0 ? in_sizes[0] : -1, out_size, ws_size, (size_t)WS_END); grid_blocks = -1; return; }
        int dev = 0, cus = 0, per_cu = 0;
        if (hipGetDevice(&dev) != hipSuccess || hipDeviceGetAttribute(&cus, hipDeviceAttributeMultiprocessorCount, dev) != hipSuccess) { grid_blocks = -1; return; }
        if (hipFuncSetAttribute((const void*)fwd_kernel, hipFuncAttributeMaxDynamicSharedMemorySize, LDS_BYTES) != hipSuccess) { fprintf(stderr, "kernel_launch: hipFuncSetAttribute failed\n"); grid_blocks = -1; return; }
        if (hipOccupancyMaxActiveBlocksPerMultiprocessor(&per_cu, (const void*)fwd_kernel, 512, LDS_BYTES) != hipSuccess || per_cu < 1) { fprintf(stderr, "kernel_launch: occupancy query says %d blocks/CU\n", per_cu); (void)hipGetLastError(); per_cu = 1; }
        grid_blocks = cus;
        if (grid_blocks % 32 != 0) { fprintf(stderr, "kernel_launch: CU count %d not a multiple of 32\n", cus); grid_blocks = (cus / 32) * 32; }
    }
    if (grid_blocks <= 0) return;
    Params p{};
    const float** f = (const float**)&p;
    for (int i = 0; i < 22; ++i) f[i] = (const float*)d_in[i];
    p.out = (float*)d_out; p.ws = (unsigned char*)d_ws; p.phases = 0x1FFFu; p.pad = 0u;
    if (hipMemsetAsync((char*)d_ws + WS_BAR, 0, 32768, stream) != hipSuccess) { fprintf(stderr, "kernel_launch: memset of the barrier words failed\n"); return; }
    void* args[] = {&p};
    hipError_t e = hipLaunchCooperativeKernel((const void*)fwd_kernel, dim3(grid_blocks), dim3(512), args, LDS_BYTES, stream);
    if (e != hipSuccess) fprintf(stderr, "cooperative launch failed: %s (grid %d)\n", hipGetErrorString(e), grid_blocks);
}
```
